# Optimizing an MI355X kernel written in HIP

```python
import jax, jax.numpy as jnp
from jax import lax
import numpy as np

D_MODEL = 1024
BATCH = 2
SEQ = 8192
DEPTH = 1

CHUNK = 64
EPS = 1e-6

SSD_HEADS = 16
SSD_HEAD_DIM = 64
SSD_INNER = SSD_HEADS * SSD_HEAD_DIM
SSD_GROUPS = 4
SSD_HPG = SSD_HEADS // SSD_GROUPS
SSD_STATE = 128
SSD_CONV = 4
SSD_CONV_CH = SSD_INNER + 2 * SSD_GROUPS * SSD_STATE

HG_HEADS = 8
HG_KDIM = 128
HG_VDIM = 128
HG_K = HG_HEADS * HG_KDIM
HG_V = HG_HEADS * HG_VDIM

MIX_WIDTH = SSD_INNER + HG_V
IN_SIZES = (SSD_INNER, SSD_CONV_CH, SSD_HEADS, HG_K, HG_K, HG_V, HG_V)
IN_COLS = SSD_INNER + SSD_CONV_CH + SSD_HEADS + 2 * HG_K + 2 * HG_V

PEER_HEADS = 8
PEER_KEYS = 128
PEER_EXPERTS = PEER_KEYS * PEER_KEYS
PEER_TOPK = 16
PEER_QDIM = 256
PEER_HALF = PEER_QDIM // 2
PEER_BLOCK = 128

kernel_name = "hymba_ssd_hgrn2_peer_block"


def rmsnorm(x, w):
    xf = x.astype(jnp.float32)
    r = xf * lax.rsqrt(jnp.mean(xf * xf, axis=-1, keepdims=True) + EPS)
    return (r * w.astype(jnp.float32)).astype(x.dtype)


def causal_dwconv(x, w, b):
    k, c = w.shape
    y = lax.conv_general_dilated(x, w[:, None, :].astype(x.dtype), window_strides=(1,),
                                 padding=[(k - 1, 0)], dimension_numbers=('NWC', 'WIO', 'NWC'),
                                 feature_group_count=c)
    return y + b.astype(x.dtype)


def segsum_exp(a):
    n = a.shape[-1]
    cs = jnp.cumsum(a, axis=-1)
    diff = cs[..., :, None] - cs[..., None, :]
    mask = jnp.tril(jnp.ones((n, n), dtype=bool))
    return jnp.where(mask, jnp.exp(jnp.where(mask, diff, 0.0)), 0.0)


def ssd_mixer(z, xbc, dt_raw, conv_w, conv_b, dt_bias, a_log, d_skip, norm_w):
    bsz, seqlen, _ = z.shape
    nc = seqlen // CHUNK
    g, r, p, n = SSD_GROUPS, SSD_HPG, SSD_HEAD_DIM, SSD_STATE
    xbc = jax.nn.silu(causal_dwconv(xbc, conv_w, conv_b))
    xs = xbc[..., :SSD_INNER].reshape(bsz, nc, CHUNK, g, r, p)
    bm = xbc[..., SSD_INNER:SSD_INNER + g * n].reshape(bsz, nc, CHUNK, g, n)
    cm = xbc[..., SSD_INNER + g * n:].reshape(bsz, nc, CHUNK, g, n)
    dt = jax.nn.softplus(dt_raw.astype(jnp.float32) + dt_bias.astype(jnp.float32))
    a_head = -jnp.exp(a_log.astype(jnp.float32))
    dt = dt.reshape(bsz, nc, CHUNK, g, r)
    a = jnp.moveaxis(dt * a_head.reshape(g, r), 2, -1)
    xdt = xs * dt[..., None]
    a_cum = jnp.cumsum(a, axis=-1)
    decay = segsum_exp(a)
    cb = jnp.einsum('bclgn,bcsgn->bcgls', cm, bm)
    y_diag = jnp.einsum('bcgrls,bcsgrp->bclgrp', cb[:, :, :, None] * decay, xdt)
    to_end = jnp.moveaxis(jnp.exp(a_cum[..., -1:] - a_cum), -1, 2)
    states = jnp.einsum('bclgn,bclgrp->bcgrpn', bm, xdt * to_end[..., None])
    chunk_decay = jnp.exp(a_cum[..., -1])

    def step(s, inp):
        st, dec = inp
        return s * dec[..., None, None] + st, s

    s0 = jnp.zeros((bsz, g, r, p, n), states.dtype)
    _, prev = lax.scan(step, s0, (jnp.moveaxis(states, 1, 0), jnp.moveaxis(chunk_decay, 1, 0)))
    prev = jnp.moveaxis(prev, 0, 1)
    from_start = jnp.moveaxis(jnp.exp(a_cum), -1, 2)
    y_off = jnp.einsum('bclgn,bcgrpn->bclgrp', cm, prev) * from_start[..., None]
    y = y_diag + y_off + xs * d_skip.reshape(g, r)[:, :, None]
    y = y.reshape(bsz, seqlen, SSD_INNER)
    return rmsnorm(y * jax.nn.silu(z.astype(y.dtype)), norm_w)


def hgrn2_mixer(q_raw, f_raw, i_raw, g_raw, lb, norm_w):
    bsz, seqlen, _ = q_raw.shape
    nc = seqlen // CHUNK
    f = lb + (1.0 - lb) * jax.nn.sigmoid(f_raw.astype(jnp.float32))
    logf = jnp.log(f)
    k = 1.0 - f
    q = jax.nn.silu(q_raw.astype(jnp.float32))
    v = i_raw.astype(jnp.float32)
    mask = jnp.tril(jnp.ones((CHUNK, CHUNK), dtype=bool))[None, :, :, None, None]

    def chunks(t, d):
        return jnp.swapaxes(t.reshape(bsz, nc, CHUNK, HG_HEADS, d), 0, 1)

    def step(s, inp):
        qc, kc, vc, gc = inp
        gcum = jnp.cumsum(gc, axis=1)
        o_inter = jnp.einsum('blhk,bhkv->blhv', qc * jnp.exp(gcum), s)
        diff = gcum[:, :, None] - gcum[:, None, :]
        dec = jnp.where(mask, jnp.exp(jnp.where(mask, diff, 0.0)), 0.0)
        att = jnp.sum(qc[:, :, None] * kc[:, None] * dec, axis=-1)
        o_intra = jnp.einsum('blsh,bshv->blhv', att, vc)
        g_end = gcum[:, -1]
        s_new = s * jnp.exp(g_end)[..., None] + jnp.einsum(
            'bshk,bshv->bhkv', kc * jnp.exp(g_end[:, None] - gcum), vc)
        return s_new, o_inter + o_intra

    s0 = jnp.zeros((bsz, HG_HEADS, HG_KDIM, HG_VDIM), jnp.float32)
    _, o = lax.scan(step, s0, (chunks(q, HG_KDIM), chunks(k, HG_KDIM),
                               chunks(v, HG_VDIM), chunks(logf, HG_KDIM)))
    o = jnp.swapaxes(o, 0, 1).reshape(bsz, seqlen, HG_HEADS, HG_VDIM)
    gate = jax.nn.silu(g_raw.astype(jnp.float32).reshape(bsz, seqlen, HG_HEADS, HG_VDIM))
    o = rmsnorm(o, norm_w.reshape(HG_HEADS, HG_VDIM)) * gate
    return o.reshape(bsz, seqlen, HG_V)


def peer_ffn(x, w_query, sub_keys, u_table, v_table):
    bsz, seqlen, dm = x.shape
    t = bsz * seqlen
    xt = x.reshape(t, dm)
    q = (xt @ w_query).reshape(t, PEER_HEADS, 2, PEER_HALF)
    s = jnp.einsum('thpd,hpnd->thpn', q, sub_keys).astype(jnp.float32)
    s_top, i_top = lax.top_k(s, PEER_TOPK)
    cand = (s_top[:, :, 0, :, None] + s_top[:, :, 1, None, :]).reshape(t, PEER_HEADS, PEER_TOPK * PEER_TOPK)
    c_top, c_idx = lax.top_k(cand, PEER_TOPK)
    idx1 = jnp.take_along_axis(i_top[:, :, 0], c_idx // PEER_TOPK, axis=-1)
    idx2 = jnp.take_along_axis(i_top[:, :, 1], c_idx % PEER_TOPK, axis=-1)
    expert = idx1 * PEER_KEYS + idx2
    gate = jax.nn.softmax(c_top, axis=-1)

    def block(args):
        xb, eb, gb = args
        u = u_table[eb]
        hid = jax.nn.gelu(jnp.einsum('td,thkd->thk', xb, u).astype(jnp.float32), approximate=False) * gb
        return jnp.einsum('thk,thkd->td', hid.astype(xb.dtype), v_table[eb])

    nb = t // PEER_BLOCK
    out = lax.map(block, (xt.reshape(nb, PEER_BLOCK, dm),
                          expert.reshape(nb, PEER_BLOCK, PEER_HEADS, PEER_TOPK),
                          gate.reshape(nb, PEER_BLOCK, PEER_HEADS, PEER_TOPK)))
    return out.reshape(bsz, seqlen, dm)


def setup_inputs(seed: int = 0) -> dict:
    key = jax.random.key(seed)
    ks = jax.random.split(key, 20)
    f32 = jnp.float32
    nrm = lambda k, shape, sc: jax.random.normal(k, shape, f32) * sc
    dt0 = jnp.exp(jax.random.uniform(ks[4], (DEPTH, SSD_HEADS), f32, np.log(1e-3), np.log(1e-1)))
    return {
        "x": nrm(ks[0], (BATCH, SEQ, D_MODEL), 1.0),
        "ln_mix_w": 1.0 + nrm(ks[1], (DEPTH, D_MODEL), 0.05),
        "w_in": nrm(ks[2], (DEPTH, D_MODEL, IN_COLS), D_MODEL ** -0.5),
        "conv_w": nrm(ks[3], (DEPTH, SSD_CONV, SSD_CONV_CH), SSD_CONV ** -0.5),
        "conv_b": nrm(ks[5], (DEPTH, SSD_CONV_CH), 0.02),
        "dt_bias": dt0 + jnp.log(-jnp.expm1(-dt0)),
        "a_log": jnp.log(jax.random.uniform(ks[6], (DEPTH, SSD_HEADS), f32, 1.0, 16.0)),
        "d_skip": 1.0 + nrm(ks[7], (DEPTH, SSD_HEADS), 0.1),
        "ssd_norm_w": 1.0 + nrm(ks[8], (DEPTH, SSD_INNER), 0.05),
        "lb_logits": 1.0 + nrm(ks[9], (DEPTH + 1, HG_K), 0.1),
        "hg_norm_w": 1.0 + nrm(ks[10], (DEPTH, HG_V), 0.05),
        "w_out": nrm(ks[11], (DEPTH, MIX_WIDTH, D_MODEL), MIX_WIDTH ** -0.5),
        "ln_ffn_w": 1.0 + nrm(ks[12], (DEPTH, D_MODEL), 0.05),
        "w_query": nrm(ks[13], (DEPTH, D_MODEL, PEER_HEADS * PEER_QDIM), D_MODEL ** -0.5),
        "sub_keys": nrm(ks[14], (DEPTH, PEER_HEADS, 2, PEER_KEYS, PEER_HALF), PEER_HALF ** -0.5),
        "u_table": nrm(ks[15], (DEPTH, PEER_EXPERTS, D_MODEL), D_MODEL ** -0.5),
        "v_table": nrm(ks[16], (DEPTH, PEER_EXPERTS, D_MODEL), 0.5),
        "ln_final_w": 1.0 + nrm(ks[17], (D_MODEL,), 0.05),
    }


def reference(x, ln_mix_w, w_in, conv_w, conv_b, dt_bias, a_log, d_skip, ssd_norm_w,
              lb_logits, hg_norm_w, w_out, ln_ffn_w, w_query, sub_keys, u_table, v_table,
              ln_final_w):
    split_at = [int(v) for v in np.cumsum(IN_SIZES)[:-1]]
    lb_all = jnp.cumsum(jax.nn.softmax(lb_logits.astype(jnp.float32), axis=0), axis=0)
    h = x
    for l in range(DEPTH):
        hn = rmsnorm(h, ln_mix_w[l])
        proj = hn @ w_in[l]
        z, xbc, dt_raw, q_raw, f_raw, i_raw, g_raw = jnp.split(proj, split_at, axis=-1)
        y_ssd = ssd_mixer(z, xbc, dt_raw, conv_w[l], conv_b[l], dt_bias[l], a_log[l],
                          d_skip[l], ssd_norm_w[l])
        y_hg = hgrn2_mixer(q_raw, f_raw, i_raw, g_raw, lb_all[l], hg_norm_w[l])
        mix = jnp.concatenate([y_ssd.astype(h.dtype), y_hg.astype(h.dtype)], axis=-1)
        h = h + mix @ w_out[l]
        h = h + peer_ffn(rmsnorm(h, ln_ffn_w[l]), w_query[l], sub_keys[l], u_table[l], v_table[l])
    return rmsnorm(h, ln_final_w)
```

```cpp
#include <hip/hip_runtime.h>
#include <cstdio>
#include <cstdint>
namespace pg8 {
#define PG8_LAS __attribute__((address_space(3)))
typedef unsigned short bf16_t;
typedef short bf16x8 __attribute__((ext_vector_type(8)));
typedef float f32x4 __attribute__((ext_vector_type(4)));
typedef unsigned u32x4 __attribute__((ext_vector_type(4)));
constexpr int BM = 256, BK = 64, HALF = 128, HTB = HALF * BK * 2  , STAGE_BYTES = 8 * HTB, NXCD = 8, WGM = 8;

__host__ __device__ __forceinline__ int lds_byte(int r, int c) { const int st = (r >> 4) * 2 + (c >> 5), rr = r & 15, cc = c & 31, ob = rr * 64 + cc * 2; return st * 1024 + (ob ^ (((ob >> 9) & 1) << 5)); }
__host__ __device__ __forceinline__ void stage_rc(int b, int& R, int& C) { const int st = b / 1024, sb = b % 1024, swz = sb ^ (((sb >> 9) & 1) << 5); R = (st >> 1) * 16 + swz / 64; C = (st & 1) * 32 + (swz % 64) / 2; }
__host__ __device__ __forceinline__ int perm32(int rho) { const int n = rho >> 4, i = rho & 15; return 8 * (i >> 2) + 4 * n + (i & 3); }

struct Unit { int pm, pn; };
struct Gemm { const bf16_t* A; const bf16_t* Bt; int M, N, K; };

struct StaticOrder {
    int nM, nN, nwg, G, c;
    __host__ __device__ void init(int M, int N, int G_, int c_) { nM = M / BM; nN = N / BM; nwg = nM * nN; G = G_; c = c_; }
    __host__ __device__ bool next(int i, Unit& u) const {
        const long L = (long)i * G + c; if (L >= nwg) return false;
        int wgid = (int)L; { const int q = nwg / NXCD, r = nwg % NXCD, xcd = wgid % NXCD, off = wgid / NXCD; wgid = (xcd < r ? xcd * (q + 1) : r * (q + 1) + (xcd - r) * q) + off; }
        const int nig = WGM * nN, gid = wgid / nig, fm = gid * WGM, gsz = (nM - fm) < WGM ? (nM - fm) : WGM;
        u.pm = fm + ((wgid % nig) % gsz); u.pn = (wgid % nig) / gsz; return true;
    }
    __device__ __forceinline__ void a_ready(const Unit&) const {}
    __device__ __forceinline__ void done(const Unit&) const {}
};

__device__ __forceinline__ unsigned cvt_pk_bf16(float lo, float hi) { unsigned r; asm volatile("v_cvt_pk_bf16_f32 %0, %1, %2" : "=v"(r) : "v"(lo), "v"(hi)); return r; }
typedef float f32x2 __attribute__((ext_vector_type(2)));
__device__ __forceinline__ f32x2 gelu_pk(f32x2 v) {
    const f32x2 av = __builtin_elementwise_abs(v), d = av * 0.2316418882f + 1.0f;
    f32x2 t; t.x = __builtin_amdgcn_rcpf(d.x); t.y = __builtin_amdgcn_rcpf(d.y);
    f32x2 q = t * 0.5307027145f + (-0.7265760135f); q = q * t + 0.7107068705f; q = q * t + (-0.142248368f); q = q * t + 0.127414796f; q = q * t;
    const f32x2 s = (v * v) * (-0.72134752044f);
    f32x2 e; e.x = __builtin_amdgcn_exp2f(s.x); e.y = __builtin_amdgcn_exp2f(s.y);
    const f32x2 m = v * (q * e), r = v - m;
    f32x2 o; o.x = v.x < 0.f ? m.x : r.x; o.y = v.y < 0.f ? m.y : r.y; return o;
}

template <int ACT  > struct EpiBf16 {
    static constexpr bool PERM = true, AFTER_DRAIN = false; static_assert(ACT == 0 || ACT == 1, "EpiBf16: ACT is 0 (none) or 1 (gelu_pk)");
    bf16_t* O; int ldc; const float* bias; int split_cols; size_t split_stride; float scale0;
    __device__ __forceinline__ void operator()(const f32x4 (&acc)[2][2][4][2], const Unit& u, int wr, int wc, int fr, int fq) const {
        const int row0 = u.pm * BM + wr * 64 + fr; int colt = u.pn * BM; bf16_t* base = O;
        float sc = 1.f; if (split_cols) { const int t = colt / split_cols; base += (size_t)t * split_stride; colt -= t * split_cols; if (t == 0) sc = scale0; }
        const int col0 = colt + wc * 32 + 8 * fq, bcol0 = u.pn * BM + wc * 32 + 8 * fq;
        f32x4 bv[2][2];
#pragma unroll
        for (int bj = 0; bj < 2; ++bj)
#pragma unroll
            for (int n = 0; n < 2; ++n) bv[bj][n] = bias ? *(const f32x4*)(bias + bcol0 + bj * HALF + 4 * n) : (f32x4){0.f, 0.f, 0.f, 0.f};
#pragma unroll
        for (int ai = 0; ai < 2; ++ai)
#pragma unroll
            for (int m = 0; m < 4; ++m) { bf16_t* rowp = base + (size_t)(row0 + ai * HALF + m * 16) * ldc + col0;
#pragma unroll
                for (int bj = 0; bj < 2; ++bj) { f32x4 v0 = acc[ai][bj][m][0] + bv[bj][0], v1 = acc[ai][bj][m][1] + bv[bj][1];
                    if (ACT == 1) { f32x2 a = gelu_pk((f32x2){v0[0], v0[1]}), b = gelu_pk((f32x2){v0[2], v0[3]}), c = gelu_pk((f32x2){v1[0], v1[1]}), d = gelu_pk((f32x2){v1[2], v1[3]});
                        v0 = (f32x4){a.x, a.y, b.x, b.y}; v1 = (f32x4){c.x, c.y, d.x, d.y}; }
                    v0 = v0 * sc; v1 = v1 * sc; u32x4 w; w.x = cvt_pk_bf16(v0[0], v0[1]); w.y = cvt_pk_bf16(v0[2], v0[3]); w.z = cvt_pk_bf16(v1[0], v1[1]); w.w = cvt_pk_bf16(v1[2], v1[3]);
                    *(u32x4*)(rowp + bj * HALF) = w; } }
    }
};
template <class Epi, class Sched, bool ALIGN_EPI = false, bool SP2 = false>
__device__ __forceinline__ void gemm_phase(PG8_LAS unsigned char* lds, const Gemm g, const Sched& S, const Epi& E) {
    int tid_ = threadIdx.x; asm volatile("" : "+v"(tid_));
    const int tid = tid_, wid = __builtin_amdgcn_readfirstlane(tid >> 6), lane = tid & 63, wr = wid >> 2, wc = wid & 3, fr = lane & 15, fq = lane >> 4;
    const int K = g.K, nt = K / BK;
    unsigned voffA[2], voffB[2];
#pragma unroll
    for (int i = 0; i < 2; ++i) { int R, C; stage_rc(tid * 16 + i * 8192, R, C); const int Rb = Epi::PERM ? ((R & ~31) + perm32(R & 31)) : R;
        voffA[i] = (unsigned)(R * K + C) * 2u; voffB[i] = (unsigned)(Rb * K + C) * 2u; }
    const size_t kstep = (size_t)(BK * 2);
    const size_t hstep = (size_t)HALF * K * 2;
    const size_t tstep = 2 * hstep;
    const unsigned ldsw = (unsigned)wid * 1024u;
    const int aoff = lds_byte(wr * 64 + fr, fq * 8), boff = lds_byte(wc * 32 + fr, fq * 8);
#define PG8_SA(b, h) (((b) * 2 + (h)) * HTB)
#define PG8_SB(b, h) ((4 + (b) * 2 + (h)) * HTB)
#define PG8_STAGE(bufoff, gbase, voff) do { _Pragma("unroll") for (int _i = 0; _i < 2; ++_i) \
        __builtin_amdgcn_global_load_lds((const unsigned*)((const char*)(gbase) + (voff)[_i]), (PG8_LAS unsigned*)(lds + (bufoff) + ldsw + _i * 8192), 16, 0, 0); } while (0)
#define PG8_LDA(dst, b, h) do { _Pragma("unroll") for (int m = 0; m < 4; ++m) _Pragma("unroll") for (int k = 0; k < 2; ++k) dst[m][k] = *(const PG8_LAS bf16x8*)(lds + PG8_SA(b, h) + aoff + m * 2048 + k * 1024); } while (0)
#define PG8_LDB(dst, b, h) do { _Pragma("unroll") for (int n = 0; n < 2; ++n) _Pragma("unroll") for (int k = 0; k < 2; ++k) dst[n][k] = *(const PG8_LAS bf16x8*)(lds + PG8_SB(b, h) + boff + n * 2048 + k * 1024); } while (0)
#define PG8_MMA(ai, bj, At, Bt) do { __builtin_amdgcn_s_setprio(1); _Pragma("unroll") for (int m = 0; m < 4; ++m) _Pragma("unroll") for (int n = 0; n < 2; ++n) _Pragma("unroll") for (int k = 0; k < 2; ++k) \
        acc[ai][bj][m][n] = __builtin_amdgcn_mfma_f32_16x16x32_bf16(Bt[n][k], At[m][k], acc[ai][bj][m][n], 0, 0, 0); __builtin_amdgcn_s_setprio(0); } while (0)
#define PG8_WAIT_V(n) asm volatile("s_waitcnt vmcnt(" #n ")" ::: "memory")
#define PG8_WAIT_L(n) asm volatile("s_waitcnt lgkmcnt(" #n ")" ::: "memory")
#define PG8_BAR __builtin_amdgcn_s_barrier()
#define PG8_SCHED __builtin_amdgcn_sched_barrier(0)
    Unit cur, nxt; int ui = 0;
    if (!S.next(0, cur)) return;
    f32x4 acc[2][2][4][2];
#pragma unroll
    for (int a = 0; a < 2; ++a)
#pragma unroll
        for (int b = 0; b < 2; ++b)
#pragma unroll
            for (int m = 0; m < 4; ++m)
#pragma unroll
                for (int n = 0; n < 2; ++n) acc[a][b][m][n] = (f32x4){0.f, 0.f, 0.f, 0.f};
    bf16x8 At[4][2], B0[2][2], B1[2][2];
    const char* cA = (const char*)g.A + (size_t)cur.pm * tstep; const char* cB = (const char*)g.Bt + (size_t)cur.pn * tstep;
    S.a_ready(cur);
    if constexpr (SP2) {
        PG8_STAGE(PG8_SB(0, 0), cB, voffB); PG8_STAGE(PG8_SB(0, 1), cB + hstep, voffB); PG8_STAGE(PG8_SA(0, 0), cA, voffA); PG8_STAGE(PG8_SA(0, 1), cA + hstep, voffA);
        if (wr == 1) PG8_BAR;
        PG8_WAIT_V(2); PG8_BAR;
        PG8_STAGE(PG8_SB(1, 0), cB + kstep, voffB); PG8_STAGE(PG8_SA(1, 0), cA + kstep, voffA); PG8_STAGE(PG8_SB(1, 1), cB + hstep + kstep, voffB);
        PG8_WAIT_V(6); PG8_BAR;
    } else {
        PG8_STAGE(PG8_SB(0, 0), cB, voffB); PG8_STAGE(PG8_SA(0, 0), cA, voffA); PG8_STAGE(PG8_SB(0, 1), cB + hstep, voffB); PG8_STAGE(PG8_SA(0, 1), cA + hstep, voffA);
        if (wr == 1) PG8_BAR;
        PG8_WAIT_V(4); PG8_BAR;
        PG8_STAGE(PG8_SB(1, 0), cB + kstep, voffB); PG8_STAGE(PG8_SA(1, 0), cA + kstep, voffA); PG8_STAGE(PG8_SB(1, 1), cB + hstep + kstep, voffB);
        PG8_WAIT_V(6); PG8_BAR;
    }
    for (;;) {
        const bool has_next = S.next(ui + 1, nxt);
        const char* nA = has_next ? (const char*)g.A + (size_t)nxt.pm * tstep : cA; const char* nB = has_next ? (const char*)g.Bt + (size_t)nxt.pn * tstep : cB;
        for (int t = 0; t < nt; t += 2) {
            const bool last = (t == nt - 2);
            const char* a1 = cA + (size_t)(t + 1) * kstep;
            const char* a2 = last ? nA : cA + (size_t)(t + 2) * kstep; const char* b2 = last ? nB : cB + (size_t)(t + 2) * kstep;
            const char* a3 = a2 + kstep; const char* b3 = b2 + kstep;
            if (last && has_next) S.a_ready(nxt);
            if constexpr (SP2) {
            PG8_LDB(B0, 0, 0); PG8_LDB(B1, 0, 1); PG8_SCHED; PG8_LDA(At, 0, 0); PG8_STAGE(PG8_SA(1, 1), a1 + hstep, voffA);
            PG8_WAIT_V(8); PG8_WAIT_L(0); PG8_BAR; PG8_MMA(0, 0, At, B0); PG8_MMA(0, 1, At, B1); PG8_BAR; PG8_SCHED;
            PG8_LDA(At, 0, 1); PG8_STAGE(PG8_SB(0, 0), b2, voffB); PG8_STAGE(PG8_SB(0, 1), b2 + hstep, voffB); PG8_STAGE(PG8_SA(0, 0), a2, voffA);
            PG8_WAIT_V(8); PG8_WAIT_L(0); PG8_BAR; PG8_MMA(1, 0, At, B0); PG8_MMA(1, 1, At, B1); PG8_BAR; PG8_SCHED;
            PG8_LDB(B0, 1, 0); PG8_LDB(B1, 1, 1); PG8_SCHED; PG8_LDA(At, 1, 0); PG8_STAGE(PG8_SA(0, 1), a2 + hstep, voffA);
            PG8_WAIT_V(8); PG8_WAIT_L(0); PG8_BAR; PG8_MMA(0, 0, At, B0); PG8_MMA(0, 1, At, B1); PG8_BAR; PG8_SCHED;
            PG8_LDA(At, 1, 1); PG8_STAGE(PG8_SB(1, 0), b3, voffB); PG8_STAGE(PG8_SB(1, 1), b3 + hstep, voffB); PG8_STAGE(PG8_SA(1, 0), a3, voffA);
            PG8_WAIT_V(8); PG8_WAIT_L(0); PG8_BAR; PG8_MMA(1, 0, At, B0); PG8_MMA(1, 1, At, B1); PG8_BAR; PG8_SCHED;
            } else {
            PG8_LDB(B0, 0, 0); PG8_SCHED; PG8_LDA(At, 0, 0); PG8_STAGE(PG8_SA(1, 1), a1 + hstep, voffA);
            PG8_WAIT_L(8); PG8_BAR; PG8_WAIT_L(0); PG8_MMA(0, 0, At, B0); PG8_BAR; PG8_SCHED;
            PG8_LDB(B1, 0, 1); PG8_STAGE(PG8_SB(0, 0), b2, voffB);
            PG8_BAR; PG8_WAIT_L(0); PG8_MMA(0, 1, At, B1); PG8_BAR;
            PG8_LDA(At, 0, 1); PG8_STAGE(PG8_SA(0, 0), a2, voffA);
            PG8_BAR; PG8_WAIT_L(0); PG8_MMA(1, 0, At, B0); PG8_BAR; PG8_SCHED;
            PG8_STAGE(PG8_SB(0, 1), b2 + hstep, voffB);
            PG8_WAIT_V(6); PG8_BAR; PG8_MMA(1, 1, At, B1); PG8_BAR;
            PG8_LDB(B0, 1, 0); PG8_SCHED; PG8_LDA(At, 1, 0); PG8_STAGE(PG8_SA(0, 1), a2 + hstep, voffA);
            PG8_WAIT_L(8); PG8_BAR; PG8_WAIT_L(0); PG8_MMA(0, 0, At, B0); PG8_BAR; PG8_SCHED;
            PG8_LDB(B1, 1, 1); PG8_STAGE(PG8_SB(1, 0), b3, voffB);
            PG8_BAR; PG8_WAIT_L(0); PG8_MMA(0, 1, At, B1); PG8_BAR;
            PG8_LDA(At, 1, 1); PG8_STAGE(PG8_SA(1, 0), a3, voffA);
            PG8_BAR; PG8_WAIT_L(0); PG8_MMA(1, 0, At, B0); PG8_BAR; PG8_SCHED;
            PG8_STAGE(PG8_SB(1, 1), b3 + hstep, voffB);
            PG8_WAIT_V(6); PG8_BAR; PG8_MMA(1, 1, At, B1); PG8_BAR;
            }
        }
        if constexpr (ALIGN_EPI) { if (wr == 0) PG8_BAR; }
        if constexpr (!Epi::AFTER_DRAIN) { E(acc, cur, wr, wc, fr, fq); S.done(cur); }
        if (!has_next) break;
#pragma unroll
        for (int a = 0; a < 2; ++a)
#pragma unroll
            for (int b = 0; b < 2; ++b)
#pragma unroll
                for (int m = 0; m < 4; ++m)
#pragma unroll
                    for (int n = 0; n < 2; ++n) acc[a][b][m][n] = (f32x4){0.f, 0.f, 0.f, 0.f};
        cur = nxt; cA = nA; cB = nB; ++ui;
        if constexpr (ALIGN_EPI) { if (wr == 1) PG8_BAR; }
    }
    PG8_WAIT_V(0);
    if constexpr (!ALIGN_EPI) { if (wr == 0) PG8_BAR; }
    PG8_BAR;
    if constexpr (Epi::AFTER_DRAIN) { E.fused(acc, cur, wr, wc, fr, fq, lds, wid, lane); S.done(cur); }
#undef PG8_SA
#undef PG8_SB
#undef PG8_STAGE
#undef PG8_LDA
#undef PG8_LDB
#undef PG8_MMA
#undef PG8_WAIT_V
#undef PG8_WAIT_L
#undef PG8_BAR
#undef PG8_SCHED
}
}

#ifndef DBGV
#define DBGV 2
#endif
#ifndef DBG
#define DBG 0
#endif
#ifndef MK_PER_PHASE
#define MK_PER_PHASE 1
#endif
constexpr int NWAVES = 8, NTHR = NWAVES * 64;
constexpr int NBATCH = 2, SEQ = 8192, T = NBATCH * SEQ, D = 1024;
constexpr int SUPER = 256, NSC = SEQ / SUPER;
constexpr int INCOLS = 7184;
constexpr int NA = 3072, NB_ = 4096;
constexpr float EPS = 1e-6f;
constexpr int NPH = 16;
constexpr size_t MiB = 1u << 20;
constexpr size_t WS_CTL = 0, CTL_ZERO_BYTES = 1 * MiB;
constexpr size_t WS_KEYS = 1 * MiB;
constexpr size_t WS_WIN = 2 * MiB;
constexpr size_t WS_WOUT = 16 * MiB;
constexpr size_t WS_WQ = 20 * MiB;
constexpr size_t WS_DT = 24 * MiB;
constexpr size_t WS_CDEC = 25 * MiB;
constexpr size_t WS_STATES = 26 * MiB;
constexpr size_t WS_HN = 58 * MiB;
constexpr size_t WS_PROJ = 90 * MiB;
constexpr size_t WS_H = WS_PROJ, WS_U = WS_PROJ + 64 * MiB, WS_VS = WS_PROJ + 96 * MiB;
constexpr size_t WS_IDX = 218 * MiB;
constexpr size_t WS_GATE = 226 * MiB;
constexpr size_t WS_HID = 234 * MiB;
constexpr size_t WS_END = 256 * MiB;
constexpr int CW_BAR = 4096;
constexpr int CW_SS1 = 32768;
constexpr int CW_SS2 = 32768 + T;
static_assert((CW_SS2 + T) * 4 <= (int)CTL_ZERO_BYTES, "ctl");
constexpr int LDS_BYTES = 147456;
constexpr int RING_BYTES = 131072, MISC_OFF = RING_BYTES + 320;

#define GAS __attribute__((address_space(1)))
#define LAS __attribute__((address_space(3)))
typedef unsigned short bf16;
typedef unsigned v4u __attribute__((ext_vector_type(4)));
typedef unsigned v2u __attribute__((ext_vector_type(2)));
typedef float f32x4 __attribute__((ext_vector_type(4)));
typedef float f32x16 __attribute__((ext_vector_type(16)));
typedef short bf16x8 __attribute__((ext_vector_type(8)));
typedef GAS unsigned gu32;
#define RLX_AGENT __ATOMIC_RELAXED, __HIP_MEMORY_SCOPE_AGENT
#define LDS_WAIT() asm volatile("s_waitcnt lgkmcnt(0)" ::: "memory")
__device__ __forceinline__ unsigned f2bf(float f) { unsigned u = __builtin_bit_cast(unsigned, f); return (u + 0x7fffu + ((u >> 16) & 1u)) >> 16; }
__device__ __forceinline__ unsigned pk2(float lo, float hi) { return f2bf(lo) | (f2bf(hi) << 16); }
__device__ __forceinline__ float bflo(unsigned w) { return __builtin_bit_cast(float, w << 16); }
__device__ __forceinline__ float bfhi(unsigned w) { return __builtin_bit_cast(float, w & 0xffff0000u); }
__device__ __forceinline__ float bf1(bf16 h) { return __builtin_bit_cast(float, (unsigned)h << 16); }
__device__ __forceinline__ float silu_f(float x) { return x / (1.f + __expf(-x)); }
__device__ __forceinline__ f32x4 mma16(bf16x8 a, bf16x8 b, f32x4 c) { return __builtin_amdgcn_mfma_f32_16x16x32_bf16(a, b, c, 0, 0, 0); }
__device__ __forceinline__ bf16x8 ldfrag(const LAS unsigned char* base, int pitchB, int row0, int k0, int lane) {
    return *(const LAS bf16x8*)(base + (row0 + (lane & 15)) * pitchB + (k0 + 8 * (lane >> 4)) * 2);
}
__device__ __forceinline__ float wave_sum(float v) {
#pragma unroll
    for (int o = 1; o < 64; o <<= 1) v += __shfl_xor(v, o);
    return v;
}
#define XB_TMO      128
#define XB_XCNT(j)  (256  + 64 * (j))
#define XB_XSUB(j)  (1280 + 64 * (j))
#define XB_XGEN(j)  (2304 + 64 * (j))
#define XB_TOP      3328
#define XB_TOPGEN   3392
#define XCD_BAR_WORDS 3456
#define XB_SPIN_CAP (1u << 18)

__device__ __forceinline__ unsigned xb_ld(unsigned* p)              { return __hip_atomic_load(p, __ATOMIC_RELAXED, __HIP_MEMORY_SCOPE_AGENT); }
__device__ __forceinline__ unsigned xb_add(unsigned* p, unsigned v) { return __hip_atomic_fetch_add(p, v, __ATOMIC_RELAXED, __HIP_MEMORY_SCOPE_AGENT); }
__device__ __forceinline__ unsigned xb_xcc_id() { return (unsigned)__builtin_amdgcn_s_getreg((3 << 11) | 20) & 0xFu; }
#define XB_SPIN(cond, bar) do { unsigned _sp = 0; while (cond) { __builtin_amdgcn_s_sleep(1); \
    if ((++_sp & 255u) == 0u) { if (xb_ld(&(bar)[XB_TMO])) break; if (_sp > XB_SPIN_CAP) { atomicAdd(&(bar)[XB_TMO], 1u); break; } } } } while (0)

struct XcdBarrier {
    unsigned* bar; unsigned x;
    volatile LAS unsigned* st;
};

__device__ __forceinline__ XcdBarrier xcd_barrier_post(unsigned* bar, volatile LAS unsigned* st) {
    XcdBarrier b; b.bar = bar; b.x = xb_xcc_id(); b.st = st;
    if (threadIdx.x == 0) (void)xb_add(&bar[XB_XCNT(b.x)], 1u);
    return b;
}
__device__ __forceinline__ void xcd_barrier_complete(unsigned* bar, unsigned x, unsigned& nloc, unsigned& nx) {
    const unsigned G = gridDim.x * gridDim.y * gridDim.z;
    unsigned sum, cnt, mine, sp = 0u;
    for (;;) {
        sum = 0u; cnt = 0u; mine = 0u;
#pragma unroll
        for (unsigned j = 0; j < 16; ++j) { const unsigned c = xb_ld(&bar[XB_XCNT(j)]); sum += c; cnt += (c > 0u) ? 1u : 0u; mine = (j == x) ? c : mine; }
        if (sum == G) break;
        __builtin_amdgcn_s_sleep(1);
        if ((++sp & 255u) == 0u) { if (xb_ld(&bar[XB_TMO])) break; if (sp > XB_SPIN_CAP) { atomicAdd(&bar[XB_TMO], 1u); break; } }
    }
    nloc = mine > 0u ? mine : 1u; nx = cnt > 0u ? cnt : 1u;
}

__device__ __forceinline__ void xcd_barrier(const XcdBarrier& b) {
    asm volatile("s_waitcnt vmcnt(0)" ::: "memory");
    __syncthreads();
    if (threadIdx.x == 0) {
        unsigned* bar = b.bar;
        __builtin_amdgcn_s_waitcnt(0);
        unsigned nloc = b.st[0], nx = b.st[1];
        if (nloc == 0u) { xcd_barrier_complete(bar, b.x, nloc, nx); b.st[0] = nloc; b.st[1] = nx; }
        const unsigned old = xb_add(&bar[XB_XSUB(b.x)], 1u);
        const unsigned gen = old / nloc;
        if (old + 1u == (gen + 1u) * nloc) {
            __builtin_amdgcn_fence(__ATOMIC_RELEASE, "agent");
            asm volatile("s_waitcnt vmcnt(0)" ::: "memory");
            const unsigned og = xb_add(&bar[XB_TOP], 1u);
            const unsigned tg = og / nx;
            if (og + 1u == (tg + 1u) * nx) xb_add(&bar[XB_TOPGEN], 1u);
            else XB_SPIN(xb_ld(&bar[XB_TOPGEN]) == tg, bar);
            __builtin_amdgcn_fence(__ATOMIC_ACQUIRE, "agent");
            xb_add(&bar[XB_XGEN(b.x)], 1u);
            asm volatile("s_waitcnt vmcnt(0)" ::: "memory");
        } else {
            XB_SPIN(xb_ld(&bar[XB_XGEN(b.x)]) == gen, bar);
            __builtin_amdgcn_fence(__ATOMIC_ACQUIRE, "agent");
            asm volatile("s_waitcnt vmcnt(0)" ::: "memory");
        }
    }
    __syncthreads();
}

struct Args { const float* in[18]; float* out; unsigned char* ws; int ph_lo, ph_hi; };
struct Frame {
    LAS unsigned char* lds;
    volatile LAS unsigned* MISC;
    gu32* ctl;
    unsigned char* ws;
    int tid, lane, wave, vcu, G;
    const Args* A;
    float* out;
};
#define BSYNC() __syncthreads()

__device__ __forceinline__ void p0_transpose_item(const float* W, int K, int ldw, int c0, bf16* WT, int n0, int k0, LAS float* scr, int lane) {
#pragma unroll 8
    for (int i = 0; i < 32; ++i) { const int kk = 2 * i + (lane >> 5); scr[kk * 33 + (lane & 31)] = W[(size_t)(k0 + kk) * ldw + c0 + (lane & 31)]; }
    LDS_WAIT(); asm volatile("" ::: "memory");
    const int c = lane & 7;
#pragma unroll
    for (int j = 0; j < 4; ++j) { const int n = (lane >> 3) + 8 * j; const LAS float* s = scr + (8 * c) * 33 + n;
        v4u o; o.x = pk2(s[0 * 33], s[1 * 33]); o.y = pk2(s[2 * 33], s[3 * 33]); o.z = pk2(s[4 * 33], s[5 * 33]); o.w = pk2(s[6 * 33], s[7 * 33]);
        *(GAS v4u*)(WT + (size_t)(n0 + n) * K + k0 + 8 * c) = o; }
    LDS_WAIT(); asm volatile("" ::: "memory");
}
__device__ __forceinline__ void p0_prologue(Frame& F) {
    const int gw = F.vcu * NWAVES + F.wave, NGW = F.G * NWAVES;
    {
        LAS float* scr = (LAS float*)(F.lds + F.wave * 8704);
        bf16* WIN = (bf16*)(F.ws + WS_WIN); bf16* WOUT = (bf16*)(F.ws + WS_WOUT); bf16* WQ = (bf16*)(F.ws + WS_WQ);
        constexpr int I_IN = (D / 64) * (7168 / 32), I_OUT = (2048 / 64) * (1024 / 32), I_Q = (1024 / 64) * (2048 / 32);
        for (int it = gw; it < I_IN + I_OUT + I_Q; it += NGW) {
            int r = it;
            if (r < I_IN) { const int nblk = 7168 / 32, kb = r / nblk, nb = r % nblk, n0 = 32 * nb; p0_transpose_item(F.A->in[2], 1024, INCOLS, n0 < NA ? n0 : n0 + 16, WIN, n0, 64 * kb, scr, F.lane); continue; } r -= I_IN;
            if (r < I_OUT) { const int nblk = 1024 / 32, kb = r / nblk, nb = r % nblk; p0_transpose_item(F.A->in[11], 2048, 1024, 32 * nb, WOUT, 32 * nb, 64 * kb, scr, F.lane); continue; } r -= I_OUT;
            { const int nblk = 2048 / 32, kb = r / nblk, nb = r % nblk; p0_transpose_item(F.A->in[13], 1024, 2048, 32 * nb, WQ, 32 * nb, 64 * kb, scr, F.lane); }
        }
    }
    {
        bf16* KEYS = (bf16*)(F.ws + WS_KEYS);
        for (int i = (F.vcu * NTHR + F.tid) * 4; i < 8 * 2 * 128 * 128; i += F.G * NTHR * 4) {
            const f32x4 v = *(const GAS f32x4*)(F.A->in[14] + i); v2u o; o.x = pk2(v.x, v.y); o.y = pk2(v.z, v.w); *(GAS v2u*)(KEYS + i) = o; }
    }
    BSYNC();
    LAS float* WDT = (LAS float*)F.lds;
    for (int i = F.tid; i < 16 * 1024; i += NTHR) { const int d = i >> 4, h = i & 15; WDT[h * 1024 + d] = F.A->in[2][(size_t)d * INCOLS + NA + h]; }
    BSYNC();
    bf16* HN = (bf16*)(F.ws + WS_HN); float* DT = (float*)(F.ws + WS_DT);
    for (int m = gw; m < T; m += NGW) {
        const GAS f32x4* xr = (const GAS f32x4*)(F.A->in[0] + (size_t)m * D) + F.lane;
        f32x4 v[4]; float s = 0.f;
#pragma unroll
        for (int j = 0; j < 4; ++j) { v[j] = xr[64 * j]; s += (v[j].x * v[j].x + v[j].y * v[j].y) + (v[j].z * v[j].z + v[j].w * v[j].w); }
        const float rstd = 1.f / sqrtf(wave_sum(s) * (1.f / D) + EPS);
        GAS v2u* o8 = (GAS v2u*)(HN + (size_t)m * D) + F.lane;
#pragma unroll
        for (int j = 0; j < 4; ++j) { const f32x4 w = *((const GAS f32x4*)F.A->in[1] + F.lane + 64 * j); v[j] = v[j] * rstd * w; v2u o; o.x = pk2(v[j].x, v[j].y); o.y = pk2(v[j].z, v[j].w); o8[64 * j] = o; }
        float p[16];
#pragma unroll 2
        for (int h = 0; h < 16; ++h) { float a = 0.f;
#pragma unroll
            for (int j = 0; j < 4; ++j) { const f32x4 w = *(const LAS f32x4*)(WDT + h * 1024 + 4 * F.lane + 256 * j); a += (v[j].x * w.x + v[j].y * w.y) + (v[j].z * w.z + v[j].w * w.w); }
            p[h] = a; }
#pragma unroll
        for (int h = 0; h < 16; ++h) p[h] = wave_sum(p[h]);
        if (F.lane < 16) { float r = p[0];
#pragma unroll
            for (int h = 1; h < 16; ++h) r = (F.lane == h) ? p[h] : r;
            const float xx = r + F.A->in[5][F.lane]; DT[(size_t)m * 16 + F.lane] = xx > 20.f ? xx : log1pf(__expf(xx)); }
    }
    BSYNC();
}

struct EpiG1b {
    static constexpr bool PERM = true, AFTER_DRAIN = false;
    bf16* O; const float* lbl;
    __device__ __forceinline__ void operator()(const pg8::f32x4 (&acc)[2][2][4][2], const pg8::Unit& u, int wr, int wc, int fr, int fq) const {
        const int row0 = u.pm * 256 + wr * 64 + fr, col0 = u.pn * 256 + wc * 32 + 8 * fq, grp = u.pn >> 2;
        float lb[2][8];
        if (grp == 1) {
#pragma unroll
            for (int bj = 0; bj < 2; ++bj)
#pragma unroll
                for (int e = 0; e < 8; ++e) { const int k = col0 - 1024 + bj * 128 + e; lb[bj][e] = 1.f / (1.f + __expf(lbl[1024 + k] - lbl[k])); }
        }
#pragma unroll
        for (int ai = 0; ai < 2; ++ai)
#pragma unroll
            for (int m = 0; m < 4; ++m) { bf16* rowp = O + (size_t)(row0 + ai * 128 + m * 16) * NB_ + col0;
#pragma unroll
                for (int bj = 0; bj < 2; ++bj) { float v[8];
#pragma unroll
                    for (int e = 0; e < 8; ++e) v[e] = acc[ai][bj][m][e >> 2][e & 3];
                    if (grp == 0 || grp == 3) {
#pragma unroll
                        for (int e = 0; e < 8; ++e) v[e] = silu_f(v[e]);
                    } else if (grp == 1) {
#pragma unroll
                        for (int e = 0; e < 8; ++e) { const float sg = 1.f / (1.f + __expf(-v[e])); v[e] = __logf(lb[bj][e] + (1.f - lb[bj][e]) * sg); }
                    }
                    v4u w; w.x = pk2(v[0], v[1]); w.y = pk2(v[2], v[3]); w.z = pk2(v[4], v[5]); w.w = pk2(v[6], v[7]);
                    *(v4u*)(rowp + bj * 128) = w; } }
    }
};
struct EpiRes {
    static constexpr bool PERM = false, AFTER_DRAIN = false;
    const float* X; float* H;
    __device__ __forceinline__ void operator()(const pg8::f32x4 (&acc)[2][2][4][2], const pg8::Unit& u, int wr, int wc, int fr, int fq) const {
        const int row0 = u.pm * 256 + wr * 64 + fr, col0 = u.pn * 256 + wc * 32 + 4 * fq;
#pragma unroll
        for (int ai = 0; ai < 2; ++ai)
#pragma unroll
            for (int m = 0; m < 4; ++m) { const size_t off = (size_t)(row0 + ai * 128 + m * 16) * D + col0;
#pragma unroll
                for (int bj = 0; bj < 2; ++bj)
#pragma unroll
                    for (int n = 0; n < 2; ++n) { const pg8::f32x4 xv = *(const pg8::f32x4*)(X + off + bj * 128 + n * 16); *(pg8::f32x4*)(H + off + bj * 128 + n * 16) = xv + acc[ai][bj][m][n]; } }
    }
};

constexpr int S_ACUM = 0, S_DTL = 4096;
constexpr int SA_XWT = 8192, SA_BMT = 45056;
constexpr int SB_CM = 8192, SB_BM = 25600, SB_XDTT = 43008, SB_CB = 79872, SB_YST = 97280;
constexpr int P72 = 144, P136 = 272;

template <bool TR>
__device__ __forceinline__ void conv8x8(const Frame& F, const bf16* P, size_t tok0, int pos0, int col0, int cch0, const float (&sc)[8], LAS unsigned char* dst, int pitchB) {
    asm volatile("" : "+v"(cch0), "+v"(col0));
    f32x4 w[4][2], bb[2];
#pragma unroll
    for (int k = 0; k < 4; ++k) { w[k][0] = *(const GAS f32x4*)(F.A->in[3] + k * 2048 + cch0); w[k][1] = *(const GAS f32x4*)(F.A->in[3] + k * 2048 + cch0 + 4); }
    bb[0] = *(const GAS f32x4*)(F.A->in[4] + cch0); bb[1] = *(const GAS f32x4*)(F.A->in[4] + cch0 + 4);
    const bf16* base = P + tok0 * NA + col0;
#pragma unroll
    for (int hf = 0; hf < 2; ++hf) {
        v4u raw[7];
#pragma unroll
        for (int rr = 0; rr < 7; ++rr) { const int dr = 4 * hf + rr - 3; const int drc = (pos0 + dr >= 0) ? dr : 0; const v4u ld = *(const GAS v4u*)(base + (long)drc * NA); raw[rr] = (pos0 + dr >= 0) ? ld : (v4u){0u, 0u, 0u, 0u}; }
#pragma unroll
        for (int c = 0; c < 8; c += 2) {
            float o[2][4];
#pragma unroll
            for (int dc = 0; dc < 2; ++dc)
#pragma unroll
                for (int t = 0; t < 4; ++t) { float a = bb[(c + dc) >> 2][(c + dc) & 3];
#pragma unroll
                    for (int k = 0; k < 4; ++k) { const unsigned ww = raw[t + k][c >> 1]; a += w[k][(c + dc) >> 2][(c + dc) & 3] * (dc ? bfhi(ww) : bflo(ww)); }
                    o[dc][t] = silu_f(a) * sc[4 * hf + t]; }
            if (TR) {
                v2u p0, p1; p0.x = pk2(o[0][0], o[0][1]); p0.y = pk2(o[0][2], o[0][3]); p1.x = pk2(o[1][0], o[1][1]); p1.y = pk2(o[1][2], o[1][3]);
                *(LAS v2u*)(dst + c * pitchB + 8 * hf) = p0; *(LAS v2u*)(dst + (c + 1) * pitchB + 8 * hf) = p1;
            } else {
#pragma unroll
                for (int t = 0; t < 4; ++t) *(LAS unsigned*)(dst + (4 * hf + t) * pitchB + 2 * c) = pk2(o[0][t], o[1][t]);
            }
        }
    }
}
__device__ __forceinline__ void ssd_acum(Frame& F, size_t tok0, int g) {
    LAS float* ACUM = (LAS float*)(F.lds + S_ACUM); LAS float* DTL = (LAS float*)(F.lds + S_DTL);
    const float* DT = (const float*)(F.ws + WS_DT);
    if (F.wave < 4) { const int r = F.wave, h = 4 * g + r; const float A = -__expf(F.A->in[6][h]);
        float dtv[4], a[4];
#pragma unroll
        for (int i = 0; i < 4; ++i) { dtv[i] = DT[(tok0 + 4 * F.lane + i) * 16 + h]; a[i] = dtv[i] * A; }
        a[1] += a[0]; a[2] += a[1]; a[3] += a[2];
        const float tot = a[3]; float sc = tot;
#pragma unroll
        for (int o = 1; o < 64; o <<= 1) { const float t = __shfl_up(sc, o); if (F.lane >= o) sc += t; }
        const float excl = sc - tot;
#pragma unroll
        for (int i = 0; i < 4; ++i) { ACUM[(4 * F.lane + i) * 4 + r] = a[i] + excl; DTL[(4 * F.lane + i) * 4 + r] = dtv[i]; }
    }
    BSYNC();
}
__device__ __forceinline__ void ssd_pass_a(Frame& F) {
    const bf16* P = (const bf16*)(F.ws + WS_PROJ); float* ST = (float*)(F.ws + WS_STATES); float* CDEC = (float*)(F.ws + WS_CDEC);
    LAS float* ACUM = (LAS float*)(F.lds + S_ACUM); LAS float* DTL = (LAS float*)(F.lds + S_DTL);
    for (int item = F.vcu; item < NBATCH * NSC * 4; item += F.G) {
        const int g = item & 3, cs = (item >> 2) % NSC, b = item / (4 * NSC);
        const size_t tok0 = (size_t)b * SEQ + (size_t)cs * SUPER;
        ssd_acum(F, tok0, g);
        const int cg = F.tid % 48, run = F.tid / 48;
        const int cch0 = cg < 32 ? g * 256 + 8 * cg : 1024 + g * 128 + 8 * (cg - 32), col0 = 1024 + cch0;
        f32x4 acc[4][4];
#pragma unroll
        for (int i = 0; i < 4; ++i)
#pragma unroll
            for (int j = 0; j < 4; ++j) acc[i][j] = (f32x4){0.f, 0.f, 0.f, 0.f};
        const int r = F.wave >> 1, nh = F.wave & 1;
#pragma unroll 1
        for (int s = 0; s < 4; ++s) {
            if (F.tid < 384) {
                float sc[8]; const int rr = (cg >> 3) & 3; const float aend = ACUM[255 * 4 + rr];
#pragma unroll
                for (int t = 0; t < 8; ++t) { const int l = 64 * s + 8 * run + t; sc[t] = cg < 32 ? DTL[l * 4 + rr] * __expf(aend - ACUM[l * 4 + rr]) : 1.f; }
                LAS unsigned char* dst = cg < 32 ? F.lds + SA_XWT + (8 * cg) * P72 : F.lds + SA_BMT + (8 * (cg - 32)) * P72;
                conv8x8<true>(F, P, tok0 + 64 * s + 8 * run, cs * SUPER + 64 * s + 8 * run, col0, cch0, sc, dst + 16 * run, P72);
            }
            BSYNC();
#pragma unroll
            for (int ks = 0; ks < 2; ++ks) { bf16x8 a[4], bb[4];
#pragma unroll
                for (int i = 0; i < 4; ++i) { a[i] = ldfrag(F.lds + SA_XWT, P72, r * 64 + 16 * i, 32 * ks, F.lane); bb[i] = ldfrag(F.lds + SA_BMT, P72, nh * 64 + 16 * i, 32 * ks, F.lane); }
#pragma unroll
                for (int i = 0; i < 4; ++i)
#pragma unroll
                    for (int j = 0; j < 4; ++j) acc[i][j] = mma16(a[i], bb[j], acc[i][j]); }
            BSYNC();
        }
        const int h = 4 * g + r; int ln = F.lane; asm volatile("" : "+v"(ln));
        float* dst = ST + ((size_t)(b * NSC + cs) * 16 + h) * 8192 + (4 * (ln >> 4)) * 128 + nh * 64 + (ln & 15);
#pragma unroll
        for (int i = 0; i < 4; ++i)
#pragma unroll
            for (int j = 0; j < 4; ++j)
#pragma unroll
                for (int e = 0; e < 4; ++e) dst[(16 * i + e) * 128 + 16 * j] = acc[i][j][e];
        if (F.tid < 4) CDEC[(b * NSC + cs) * 16 + 4 * g + F.tid] = __expf(ACUM[255 * 4 + F.tid]);
        BSYNC();
    }
}
__device__ __forceinline__ void ssd_scan(Frame& F) {
    float* ST = (float*)(F.ws + WS_STATES); const float* CDEC = (const float*)(F.ws + WS_CDEC);
    for (int e = F.vcu * NTHR + F.tid; e < NBATCH * 16 * 8192; e += F.G * NTHR) {
        const int el = e & 8191, h = (e >> 13) & 15, b = e >> 17; float run = 0.f;
        for (int c = 0; c < NSC; ++c) { const size_t o = ((size_t)(b * NSC + c) * 16 + h) * 8192 + el; const float loc = ST[o]; ST[o] = run; run = run * CDEC[(b * NSC + c) * 16 + h] + loc; }
    }
}
__device__ __forceinline__ void ssd_pass_b(Frame& F) {
    const bf16* P = (const bf16*)(F.ws + WS_PROJ); const float* ST = (const float*)(F.ws + WS_STATES);
    bf16* MIX = (bf16*)F.out; float* SS1 = (float*)(F.ctl + CW_SS1);
    LAS float* ACUM = (LAS float*)(F.lds + S_ACUM); LAS float* DTL = (LAS float*)(F.lds + S_DTL);
    LAS float* CB = (LAS float*)(F.lds + SB_CB);
    for (int item = F.vcu; item < NBATCH * NSC * 4; item += F.G) {
        const int g = item & 3, cs = (item >> 2) % NSC, b = item / (4 * NSC);
        const size_t tok0 = (size_t)b * SEQ + (size_t)cs * SUPER;
        ssd_acum(F, tok0, g);
        const int cg = F.tid % 48, run = F.tid / 48;
        const int cch0 = cg < 32 ? g * 256 + 8 * cg : 1024 + g * 128 + 8 * (cg - 32), col0 = 1024 + cch0;
        const int r = F.wave >> 1, lh = F.wave & 1, h = 4 * g + r;
        const float Dh = F.A->in[7][h];
        const float* prev = ST + ((size_t)(b * NSC + cs) * 16 + h) * 8192;
#pragma unroll 1
        for (int i = 0; i < 4; ++i) {
            if (F.tid < 128) { const int rn = F.tid >> 4, cgc = F.tid & 15, cchc = 1536 + g * 128 + 8 * cgc; float sc[8];
#pragma unroll
                for (int t = 0; t < 8; ++t) sc[t] = 1.f;
                conv8x8<false>(F, P, tok0 + 64 * i + 8 * rn, cs * SUPER + 64 * i + 8 * rn, 1024 + cchc, cchc, sc, F.lds + SB_CM + (8 * rn) * P136 + 16 * cgc, P136); }
            BSYNC();
            f32x4 y[2][4];
#pragma unroll
            for (int a = 0; a < 2; ++a)
#pragma unroll
                for (int c = 0; c < 4; ++c) y[a][c] = (f32x4){0.f, 0.f, 0.f, 0.f};
#pragma unroll 1
            for (int ks = 0; ks < 4; ++ks) { bf16x8 a0 = ldfrag(F.lds + SB_CM, P136, 32 * lh, 32 * ks, F.lane), a1 = ldfrag(F.lds + SB_CM, P136, 32 * lh + 16, 32 * ks, F.lane);
#pragma unroll
                for (int pt = 0; pt < 4; ++pt) { const float* pp = prev + (16 * pt + (F.lane & 15)) * 128 + 32 * ks + 8 * (F.lane >> 4);
                    const f32x4 u0 = *(const GAS f32x4*)pp, u1 = *(const GAS f32x4*)(pp + 4);
                    v4u w; w.x = pk2(u0.x, u0.y); w.y = pk2(u0.z, u0.w); w.z = pk2(u1.x, u1.y); w.w = pk2(u1.z, u1.w);
                    const bf16x8 bb = __builtin_bit_cast(bf16x8, w);
                    y[0][pt] = mma16(a0, bb, y[0][pt]); y[1][pt] = mma16(a1, bb, y[1][pt]); } }
#pragma unroll
            for (int a = 0; a < 2; ++a)
#pragma unroll
                for (int e = 0; e < 4; ++e) { const float sc = __expf(ACUM[(64 * i + 32 * lh + 16 * a + 4 * (F.lane >> 4) + e) * 4 + r]);
#pragma unroll
                    for (int pt = 0; pt < 4; ++pt) y[a][pt][e] *= sc; }
#pragma unroll 1
            for (int j = 0; j <= i; ++j) {
                BSYNC();
                if (F.tid < 384) {
                    float sc[8]; const int rr = (cg >> 3) & 3;
#pragma unroll
                    for (int t = 0; t < 8; ++t) sc[t] = cg < 32 ? DTL[(64 * j + 8 * run + t) * 4 + rr] : 1.f;
                    if (cg < 32) conv8x8<true>(F, P, tok0 + 64 * j + 8 * run, cs * SUPER + 64 * j + 8 * run, col0, cch0, sc, F.lds + SB_XDTT + (8 * cg) * P72 + 16 * run, P72);
                    else conv8x8<false>(F, P, tok0 + 64 * j + 8 * run, cs * SUPER + 64 * j + 8 * run, col0, cch0, sc, F.lds + SB_BM + (8 * run) * P136 + 16 * (cg - 32), P136);
                }
                BSYNC();
#pragma unroll
                for (int e2 = 0; e2 < 2; ++e2) { const int tt = 2 * F.wave + e2, rt = tt >> 2, ct = tt & 3; f32x4 c = (f32x4){0.f, 0.f, 0.f, 0.f};
#pragma unroll
                    for (int ks = 0; ks < 4; ++ks) c = mma16(ldfrag(F.lds + SB_CM, P136, 16 * rt, 32 * ks, F.lane), ldfrag(F.lds + SB_BM, P136, 16 * ct, 32 * ks, F.lane), c);
#pragma unroll
                    for (int e = 0; e < 4; ++e) CB[(16 * rt + 4 * (F.lane >> 4) + e) * 68 + 16 * ct + (F.lane & 15)] = c[e]; }
                BSYNC();
#pragma unroll
                for (int a = 0; a < 2; ++a) { const int l = 32 * lh + 16 * a + (F.lane & 15); const float al = ACUM[(64 * i + l) * 4 + r]; const bool diag = (i == j); const float ddt = Dh / DTL[(64 * i + l) * 4 + r];
#pragma unroll
                    for (int ks = 0; ks < 2; ++ks) { const int s0 = 32 * ks + 8 * (F.lane >> 4);
                        const f32x4 c0 = *(const LAS f32x4*)(CB + l * 68 + s0), c1 = *(const LAS f32x4*)(CB + l * 68 + s0 + 4);
                        float m[8];
#pragma unroll
                        for (int e = 0; e < 8; ++e) { const int s = s0 + e; const float as = ACUM[(64 * j + s) * 4 + r]; const float cbv = e < 4 ? c0[e] : c1[e - 4];
                            float v = cbv * __expf(fminf(al - as, 0.f));
                            v = (diag && s > l) ? 0.f : v; v += (diag && s == l) ? ddt : 0.f;
                            m[e] = v; }
                        v4u w; w.x = pk2(m[0], m[1]); w.y = pk2(m[2], m[3]); w.z = pk2(m[4], m[5]); w.w = pk2(m[6], m[7]);
                        const bf16x8 ma = __builtin_bit_cast(bf16x8, w);
#pragma unroll
                        for (int pt = 0; pt < 4; ++pt) y[a][pt] = mma16(ma, ldfrag(F.lds + SB_XDTT, P72, r * 64 + 16 * pt, 32 * ks, F.lane), y[a][pt]);
                        __builtin_amdgcn_sched_barrier(0); } }
            }
            int ln2 = F.lane; asm volatile("" : "+v"(ln2)); LAS unsigned char* ystb = F.lds + SB_YST + (32 * lh + 4 * (ln2 >> 4)) * 528 + (r * 64 + (ln2 & 15)) * 2;
#pragma unroll
            for (int a = 0; a < 2; ++a)
#pragma unroll
                for (int pt = 0; pt < 4; ++pt)
#pragma unroll
                    for (int e = 0; e < 4; ++e) *(LAS bf16*)(ystb + (16 * a + e) * 528 + (16 * pt) * 2) = (bf16)f2bf(y[a][pt][e]);
            BSYNC();
#pragma unroll
            for (int q = 0; q < 4; ++q) { const int idx = F.tid + NTHR * q, l = idx >> 5, c8 = idx & 31; const size_t tok = tok0 + 64 * i + l;
                const v4u yv = *(const LAS v4u*)(F.lds + SB_YST + l * 528 + 16 * c8); const v4u zv = *(const GAS v4u*)(P + tok * NA + g * 256 + 8 * c8);
                float o[8]; float ss = 0.f;
#pragma unroll
                for (int e = 0; e < 4; ++e) { o[2 * e] = bflo(yv[e]) * silu_f(bflo(zv[e])); o[2 * e + 1] = bfhi(yv[e]) * silu_f(bfhi(zv[e])); ss += o[2 * e] * o[2 * e] + o[2 * e + 1] * o[2 * e + 1]; }
                v4u w; w.x = pk2(o[0], o[1]); w.y = pk2(o[2], o[3]); w.z = pk2(o[4], o[5]); w.w = pk2(o[6], o[7]);
                *(GAS v4u*)(MIX + tok * 2048 + g * 256 + 8 * c8) = w;
#pragma unroll
                for (int o2 = 1; o2 < 32; o2 <<= 1) ss += __shfl_xor(ss, o2);
                if (c8 == 0) atomicAdd(SS1 + tok, ss); }
            BSYNC();
        }
    }
}
__device__ __forceinline__ void ssd_norm(Frame& F) {
    bf16* MIX = (bf16*)F.out; const float* SS1 = (const float*)(F.ctl + CW_SS1);
    const int gw = F.vcu * NWAVES + F.wave, NGW = F.G * NWAVES;
    for (int m = gw; m < T; m += NGW) { const float rstd = 1.f / sqrtf(__hip_atomic_load(SS1 + m, RLX_AGENT) * (1.f / 1024.f) + EPS);
#pragma unroll
        for (int j = 0; j < 2; ++j) { GAS v4u* p = (GAS v4u*)(MIX + (size_t)m * 2048 + 512 * j) + F.lane; const v4u v = *p; const float* w = F.A->in[8] + 512 * j + 8 * F.lane; v4u o;
#pragma unroll
            for (int e = 0; e < 4; ++e) o[e] = DBG == 3 ? 0u : pk2(bflo(v[e]) * rstd * w[2 * e], bfhi(v[e]) * rstd * w[2 * e + 1]);
            *p = o; } }
}

constexpr int H_QG = 0, H_KG = 17408, H_KENDT = 34816, H_VT = 53248, H_ATT = 71680, H_ST = 80896, H_GQ = 115712, H_DEC = 117760, H_SSQ = 118272;
template <bool PASS_B>
__device__ __forceinline__ void hg_pass(Frame& F) {
    const bf16* P = (const bf16*)(F.ws + WS_PROJ); float* STG = (float*)(F.ws + WS_STATES); float* CDEC = (float*)(F.ws + WS_CDEC) + 4096;
    bf16* MIX = (bf16*)F.out;
    LAS float* GQ = (LAS float*)(F.lds + H_GQ); LAS float* DEC = (LAS float*)(F.lds + H_DEC); LAS float* SSQ = (LAS float*)(F.lds + H_SSQ);
    const int k = F.tid & 127, qtr = F.tid >> 7, w = F.wave;
    for (int item = F.vcu; item < NBATCH * NSC * 8; item += F.G) {
        const int h = item & 7, cs = (item >> 3) % NSC, b = item / (8 * NSC);
        const size_t tok0 = (size_t)b * SEQ + (size_t)cs * SUPER;
        float* stg = STG + ((size_t)(b * NSC + cs) * 8 + h) * 16384;
        int ln = F.lane; asm volatile("" : "+v"(ln)); const int lbase = (16 * w + 4 * (ln >> 4)) * 128 + (ln & 15);
        f32x4 S[8];
#pragma unroll
        for (int kt = 0; kt < 8; ++kt) {
            if (PASS_B) {
#pragma unroll
                for (int e = 0; e < 4; ++e) S[kt][e] = stg[lbase + e * 128 + 16 * kt];
            } else S[kt] = (f32x4){0.f, 0.f, 0.f, 0.f};
        }
        if (PASS_B) {
#pragma unroll
            for (int kt = 0; kt < 8; ++kt)
#pragma unroll
                for (int e = 0; e < 4; ++e) *(LAS bf16*)(F.lds + H_ST + (16 * w + 4 * (ln >> 4)) * 272 + (ln & 15) * 2 + e * 272 + 32 * kt) = (bf16)f2bf(S[kt][e]);
        }
        float gtot = 0.f;
#pragma unroll 1
        for (int j = 0; j < 4; ++j) {
            const size_t trow = tok0 + 64 * j + 16 * qtr;
            float lf[16]; v4u wv[2];
#pragma unroll
            for (int t = 0; t < 16; t += 2) { lf[t] = bf1(P[(trow + t) * NB_ + 1024 + h * 128 + k]); lf[t + 1] = bf1(P[(trow + t + 1) * NB_ + 1024 + h * 128 + k]);
                wv[t >> 3][(t >> 1) & 3] = (unsigned)P[(trow + t) * NB_ + 2048 + h * 128 + k] | ((unsigned)P[(trow + t + 1) * NB_ + 2048 + h * 128 + k] << 16); }
            float cum[16]; cum[0] = lf[0];
#pragma unroll
            for (int t = 1; t < 16; ++t) cum[t] = cum[t - 1] + lf[t];
            GQ[qtr * 128 + k] = cum[15];
            BSYNC();
            float pre = 0.f, gend = 0.f;
#pragma unroll
            for (int q2 = 0; q2 < 4; ++q2) { const float gq = GQ[q2 * 128 + k]; if (q2 < qtr) pre += gq; gend += gq; }
            gtot += gend;
            if (qtr == 0) DEC[k] = __expf(gend);
            {   v4u wk[2];
#pragma unroll
                for (int t = 0; t < 16; t += 2) { float ke[2];
#pragma unroll
                    for (int u = 0; u < 2; ++u) { const float kk = 1.f - __expf(lf[t + u]); ke[u] = kk * __expf(gend - (pre + cum[t + u])); }
                    wk[t >> 3][(t >> 1) & 3] = pk2(ke[0], ke[1]); }
                *(LAS v4u*)(F.lds + H_KENDT + k * P72 + 32 * qtr) = wk[0]; *(LAS v4u*)(F.lds + H_KENDT + k * P72 + 32 * qtr + 16) = wk[1];
                *(LAS v4u*)(F.lds + H_VT + k * P72 + 32 * qtr) = wv[0]; *(LAS v4u*)(F.lds + H_VT + k * P72 + 32 * qtr + 16) = wv[1];
            }
            if (PASS_B) {
#pragma unroll
                for (int t = 0; t < 16; ++t) { const float gc = pre + cum[t]; const float q = bf1(P[(trow + t) * NB_ + h * 128 + k]); const float kk = 1.f - __expf(lf[t]);
                    *(LAS bf16*)(F.lds + H_QG + (16 * qtr + t) * P136 + 2 * k) = (bf16)f2bf(q * __expf(gc));
                    *(LAS bf16*)(F.lds + H_KG + (16 * qtr + t) * P136 + 2 * k) = (bf16)f2bf(kk * __expf(-gc)); }
            }
            BSYNC();
            f32x4 o[4];
            if (PASS_B) {
#pragma unroll
                for (int e2 = 0; e2 < 2; ++e2) { const int tt = 2 * w + e2, rt = tt >> 2, ct = tt & 3; f32x4 c = (f32x4){0.f, 0.f, 0.f, 0.f};
#pragma unroll
                    for (int ks = 0; ks < 4; ++ks) c = mma16(ldfrag(F.lds + H_QG, P136, 16 * rt, 32 * ks, F.lane), ldfrag(F.lds + H_KG, P136, 16 * ct, 32 * ks, F.lane), c);
#pragma unroll
                    for (int e = 0; e < 4; ++e) { const int l = 16 * rt + 4 * (F.lane >> 4) + e, s = 16 * ct + (F.lane & 15);
                        *(LAS bf16*)(F.lds + H_ATT + l * P72 + 2 * s) = (bf16)f2bf(s <= l ? c[e] : 0.f); } }
#pragma unroll
                for (int lt = 0; lt < 4; ++lt) o[lt] = (f32x4){0.f, 0.f, 0.f, 0.f};
#pragma unroll
                for (int ks = 0; ks < 4; ++ks) { const bf16x8 bb = ldfrag(F.lds + H_ST, P136, 16 * w, 32 * ks, F.lane);
#pragma unroll
                    for (int lt = 0; lt < 4; ++lt) o[lt] = mma16(ldfrag(F.lds + H_QG, P136, 16 * lt, 32 * ks, F.lane), bb, o[lt]); }
                BSYNC();
#pragma unroll
                for (int ks = 0; ks < 2; ++ks) { const bf16x8 bb = ldfrag(F.lds + H_VT, P72, 16 * w, 32 * ks, F.lane);
#pragma unroll
                    for (int lt = 0; lt < 4; ++lt) o[lt] = mma16(ldfrag(F.lds + H_ATT, P72, 16 * lt, 32 * ks, F.lane), bb, o[lt]); }
            }
#pragma unroll
            for (int kt = 0; kt < 8; ++kt) { const float dk = DEC[16 * kt + (F.lane & 15)]; S[kt] = S[kt] * dk; }
#pragma unroll
            for (int ks = 0; ks < 2; ++ks) { const bf16x8 a = ldfrag(F.lds + H_VT, P72, 16 * w, 32 * ks, F.lane);
#pragma unroll
                for (int kt = 0; kt < 8; ++kt) S[kt] = mma16(a, ldfrag(F.lds + H_KENDT, P72, 16 * kt, 32 * ks, F.lane), S[kt]); }
            if (PASS_B) {
                int l3 = F.lane; asm volatile("" : "+v"(l3)); LAS unsigned char* stb = F.lds + H_ST + (16 * w + 4 * (l3 >> 4)) * P136 + (l3 & 15) * 2;
#pragma unroll
                for (int kt = 0; kt < 8; ++kt)
#pragma unroll
                    for (int e = 0; e < 4; ++e) *(LAS bf16*)(stb + e * P136 + 32 * kt) = (bf16)f2bf(S[kt][e]);
#pragma unroll
                for (int lt = 0; lt < 4; ++lt)
#pragma unroll
                    for (int e = 0; e < 4; ++e) { float ss = o[lt][e] * o[lt][e];
#pragma unroll
                        for (int o2 = 1; o2 < 16; o2 <<= 1) ss += __shfl_xor(ss, o2);
                        if ((F.lane & 15) == 0) SSQ[(16 * lt + 4 * (F.lane >> 4) + e) * 8 + w] = ss; }
                BSYNC();
                const int vcol = 16 * w + (F.lane & 15); const float nw = F.A->in[10][h * 128 + vcol];
#pragma unroll
                for (int lt = 0; lt < 4; ++lt)
#pragma unroll
                    for (int e = 0; e < 4; ++e) { const int l = 16 * lt + 4 * (F.lane >> 4) + e; const f32x4 s0 = *(const LAS f32x4*)(SSQ + l * 8), s1 = *(const LAS f32x4*)(SSQ + l * 8 + 4);
                        const float rstd = 1.f / sqrtf(((s0.x + s0.y) + (s0.z + s0.w) + (s1.x + s1.y) + (s1.z + s1.w)) * (1.f / 128.f) + EPS);
                        const size_t tok = tok0 + 64 * j + l; const float gt = bf1(P[tok * NB_ + 3072 + h * 128 + vcol]);
                        MIX[tok * 2048 + 1024 + h * 128 + vcol] = (bf16)f2bf(DBG == 2 ? 0.f : o[lt][e] * rstd * nw * gt); }
            }
            BSYNC();
        }
        if (!PASS_B) {
            int l4 = F.lane; asm volatile("" : "+v"(l4)); const int lb2 = (16 * w + 4 * (l4 >> 4)) * 128 + (l4 & 15);
#pragma unroll
            for (int kt = 0; kt < 8; ++kt)
#pragma unroll
                for (int e = 0; e < 4; ++e) stg[lb2 + e * 128 + 16 * kt] = S[kt][e];
            if (qtr == 0) CDEC[((b * NSC + cs) * 8 + h) * 128 + k] = __expf(gtot);
        }
        BSYNC();
    }
}
__device__ __forceinline__ void hg_scan(Frame& F) {
    float* ST = (float*)(F.ws + WS_STATES); const float* CDEC = (const float*)(F.ws + WS_CDEC) + 4096;
    for (int e = F.vcu * NTHR + F.tid; e < NBATCH * 8 * 16384; e += F.G * NTHR) {
        const int el = e & 16383, kk = el & 127, h = (e >> 14) & 7, b = e >> 17; float run = 0.f;
        for (int c = 0; c < NSC; ++c) { const size_t o = ((size_t)(b * NSC + c) * 8 + h) * 16384 + el; const float loc = ST[o]; ST[o] = run; run = run * CDEC[((b * NSC + c) * 8 + h) * 128 + kk] + loc; }
    }
}

__device__ __forceinline__ void peer_prep(Frame& F) {
    const int gw = F.vcu * NWAVES + F.wave, NGW = F.G * NWAVES;
    const float* H = (const float*)(F.ws + WS_H); bf16* XN = (bf16*)(F.ws + WS_HN); bf16* U = (bf16*)(F.ws + WS_U); bf16* VS = (bf16*)(F.ws + WS_VS);
    for (int m = gw; m < T; m += NGW) {
        const GAS f32x4* xr = (const GAS f32x4*)(H + (size_t)m * D) + F.lane; f32x4 v[4]; float s = 0.f;
#pragma unroll
        for (int j = 0; j < 4; ++j) { v[j] = xr[64 * j]; s += (v[j].x * v[j].x + v[j].y * v[j].y) + (v[j].z * v[j].z + v[j].w * v[j].w); }
        const float rstd = 1.f / sqrtf(wave_sum(s) * (1.f / D) + EPS);
        GAS v2u* o8 = (GAS v2u*)(XN + (size_t)m * D) + F.lane;
#pragma unroll
        for (int j = 0; j < 4; ++j) { const f32x4 w = *((const GAS f32x4*)F.A->in[12] + F.lane + 64 * j); v[j] = v[j] * rstd * w; v2u o; o.x = pk2(v[j].x, v[j].y); o.y = pk2(v[j].z, v[j].w); o8[64 * j] = o; }
    }
    for (int e = gw; e < 16384; e += NGW) {
        const GAS f32x4* ur = (const GAS f32x4*)(F.A->in[15] + (size_t)e * D) + F.lane; const GAS f32x4* vr = (const GAS f32x4*)(F.A->in[16] + (size_t)e * D) + F.lane;
#pragma unroll
        for (int j = 0; j < 4; ++j) { const f32x4 a = ur[64 * j], c = vr[64 * j]; v2u o; o.x = pk2(a.x, a.y); o.y = pk2(a.z, a.w); *((GAS v2u*)(U + (size_t)e * D) + F.lane + 64 * j) = o;
            const int d = 4 * F.lane + 256 * j; v2u p; p.x = pk2(c.x, c.y); p.y = pk2(c.z, c.w); *(GAS v2u*)(VS + ((size_t)(d >> 7) * 16384 + e) * 128 + (d & 127)) = p; }
    }
}
__device__ __forceinline__ void cas(float& hi, float& lo) { float a, b; asm("v_max_f32 %0, %1, %2" : "=v"(a) : "v"(hi), "v"(lo)); asm("v_min_f32 %0, %1, %2" : "=v"(b) : "v"(hi), "v"(lo)); hi = a; lo = b; }
__device__ __forceinline__ float vmaxf(float x, float y) { float a; asm("v_max_f32 %0, %1, %2" : "=v"(a) : "v"(x), "v"(y)); return a; }
__device__ __forceinline__ void bitonic_merge16(float (&v)[16]) {
#pragma unroll
    for (int j = 8; j >= 1; j >>= 1)
#pragma unroll
        for (int i = 0; i < 16; ++i) { const int l = i ^ j; if (l > i) cas(v[i], v[l]); }
}
__device__ __forceinline__ void sort16(float (&v)[16]) {
#pragma unroll
    for (int k = 2; k <= 16; k <<= 1)
#pragma unroll
        for (int j = k >> 1; j >= 1; j >>= 1)
#pragma unroll
            for (int i = 0; i < 16; ++i) { const int l = i ^ j; if (l > i) { if ((i & k) == 0) cas(v[i], v[l]); else cas(v[l], v[i]); } }
}
__device__ __forceinline__ void top16_merge(float (&x)[16], const float (&y)[16]) {
#pragma unroll
    for (int i = 0; i < 16; ++i) x[i] = vmaxf(x[i], y[15 - i]);
    bitonic_merge16(x);
}
template <bool XLANE = true>
__device__ __forceinline__ void top16_of_acc(const f32x16 (&acc)[4], int hi, float (&out)[16]) {
    float l0[16], l1[16];
#pragma unroll
    for (int rt = 0; rt < 4; ++rt) { float v[16];
#pragma unroll
        for (int e = 0; e < 16; ++e) { const unsigned n = 32 * rt + (e & 3) + 8 * (e >> 2) + 4 * hi; const float sv = acc[rt][e];
            v[e] = __builtin_bit_cast(float, (__builtin_bit_cast(unsigned, sv) & ~0x7Fu) | n); }
        __builtin_amdgcn_sched_barrier(0); sort16(v); __builtin_amdgcn_sched_barrier(0);
        if (rt == 0) {
#pragma unroll
            for (int e = 0; e < 16; ++e) l0[e] = v[e];
        } else if (rt == 1) top16_merge(l0, v);
        else if (rt == 2) {
#pragma unroll
            for (int e = 0; e < 16; ++e) l1[e] = v[e];
        } else top16_merge(l1, v); }
    top16_merge(l0, l1);
    if (XLANE) {
#pragma unroll
        for (int e = 0; e < 16; ++e) l1[e] = __shfl_xor(l0[e], 32);
        top16_merge(l0, l1);
    }
#pragma unroll
    for (int e = 0; e < 16; ++e) out[e] = l0[e];
}
__device__ __forceinline__ void emit_topk(const float (&ab)[2][16], int hi, int* IDX, float* GATE, size_t tok, int hh) {
    float pcs[50]; int nc = 0;
#pragma unroll
    for (int i = 0; i < 16; ++i)
#pragma unroll
        for (int j = 0; j < 16; ++j) if ((i + 1) * (j + 1) <= 16) {
            const float c = __builtin_bit_cast(float, __builtin_bit_cast(unsigned, ab[0][i]) & ~0x7Fu) + __builtin_bit_cast(float, __builtin_bit_cast(unsigned, ab[1][j]) & ~0x7Fu);
            pcs[nc] = __builtin_bit_cast(float, (__builtin_bit_cast(unsigned, c) & ~0x3Fu) | (unsigned)nc); ++nc; }
    float thr, mx;
    {   float c0[16], c1[16];
#pragma unroll
        for (int e = 0; e < 16; ++e) { c0[e] = pcs[e]; c1[e] = pcs[16 + e]; }
        sort16(c0); __builtin_amdgcn_sched_barrier(0); sort16(c1); __builtin_amdgcn_sched_barrier(0); top16_merge(c0, c1); __builtin_amdgcn_sched_barrier(0);
#pragma unroll
        for (int e = 0; e < 16; ++e) c1[e] = pcs[32 + e];
        sort16(c1); __builtin_amdgcn_sched_barrier(0); top16_merge(c0, c1); __builtin_amdgcn_sched_barrier(0);
#pragma unroll
        for (int x = 48; x < 50; ++x) { float v = pcs[x];
#pragma unroll
            for (int e = 0; e < 16; ++e) cas(c0[e], v); }
        thr = c0[15]; mx = __builtin_bit_cast(float, __builtin_bit_cast(unsigned, c0[0]) & ~0x3Fu); }
    asm volatile("" : "+v"(thr), "+v"(mx));
    float den = 0.f;
#pragma unroll
    for (int q = 0; q < 50; ++q) { const float c = __builtin_bit_cast(float, __builtin_bit_cast(unsigned, pcs[q]) & ~0x3Fu); if (pcs[q] >= thr) den += __expf(c - mx); }
    const float rden = 1.f / den; int cnt = 0; nc = 0;
#pragma unroll
    for (int i = 0; i < 16; ++i)
#pragma unroll
        for (int j = 0; j < 16; ++j) if ((i + 1) * (j + 1) <= 16) {
            const float pc = pcs[nc]; ++nc; const float c = __builtin_bit_cast(float, __builtin_bit_cast(unsigned, pc) & ~0x3Fu);
            if (pc >= thr && hi == 0 && cnt < 16) {
                const int ex = (int)(((__builtin_bit_cast(unsigned, ab[0][i]) & 0x7Fu) << 7) | (__builtin_bit_cast(unsigned, ab[1][j]) & 0x7Fu));
                IDX[(size_t)tok * 128 + hh * 16 + cnt] = ex; GATE[(size_t)tok * 128 + hh * 16 + cnt] = __expf(c - mx) * rden; ++cnt; } }
}
__device__ __forceinline__ void peer_topk(Frame& F) {
    const bf16* Q = (const bf16*)F.out; const bf16* KEYS = (const bf16*)(F.ws + WS_KEYS); int* IDX = (int*)(F.ws + WS_IDX); float* GATE = (float*)(F.ws + WS_GATE);
    const int gw = F.vcu * NWAVES + F.wave, NGW = F.G * NWAVES;
    for (int it = gw; it < (T / 32) * 8; it += NGW) {
        const int hh = it & 7, t0 = (it >> 3) * 32, tok = t0 + (F.lane & 31), hi = F.lane >> 5;
        float ab[2][16];
#pragma unroll
        for (int p = 0; p < 2; ++p) {
            f32x16 acc[4];
#pragma unroll
            for (int rt = 0; rt < 4; ++rt)
#pragma unroll
                for (int e = 0; e < 16; ++e) acc[rt][e] = 0.f;
#pragma unroll 1
            for (int ks = 0; ks < 8; ++ks) { const bf16x8 bq = *(const GAS bf16x8*)(Q + (size_t)tok * 2048 + hh * 256 + p * 128 + 16 * ks + 8 * hi);
#pragma unroll
                for (int rt = 0; rt < 4; ++rt) { const bf16x8 ak = *(const GAS bf16x8*)(KEYS + ((size_t)(hh * 2 + p) * 128 + 32 * rt + (F.lane & 31)) * 128 + 16 * ks + 8 * hi);
                    acc[rt] = __builtin_amdgcn_mfma_f32_32x32x16_bf16(ak, bq, acc[rt], 0, 0, 0); } }
            top16_of_acc(acc, hi, ab[p]);
        }
        emit_topk(ab, hi, IDX, GATE, (size_t)tok, hh);
    }
}
__device__ __forceinline__ void peer_e1(Frame& F) {
    const bf16* XN = (const bf16*)(F.ws + WS_HN); const bf16* U = (const bf16*)(F.ws + WS_U); const int* IDX = (const int*)(F.ws + WS_IDX);
    const float* GATE = (const float*)(F.ws + WS_GATE); float* HID = (float*)(F.ws + WS_HID);
    LAS int* LST = (LAS int*)(F.lds + F.wave * 1024);
    for (int item = blockIdx.x; item < 8 * (T / 32); item += F.G) {
        const int slice = item & 7, tile = item >> 3;
        for (int tt = 0; tt < 4; ++tt) {
            const int tok = tile * 32 + F.wave * 4 + tt;
            const int e0 = IDX[(size_t)tok * 128 + F.lane], e1 = IDX[(size_t)tok * 128 + 64 + F.lane];
            const bool m0 = (e0 >> 11) == slice, m1 = (e1 >> 11) == slice;
            const unsigned long long b0 = __ballot(m0), b1 = __ballot(m1);
            const int n0 = __popcll(b0), n = n0 + __popcll(b1);
            const unsigned long long below = (1ull << F.lane) - 1ull;
            if (m0) { const int p = __popcll(b0 & below); LST[2 * p] = e0; LST[2 * p + 1] = F.lane; }
            if (m1) { const int p = n0 + __popcll(b1 & below); LST[2 * p] = e1; LST[2 * p + 1] = 64 + F.lane; }
            const v4u xa = *(const GAS v4u*)(XN + (size_t)tok * D + 8 * F.lane), xb = *(const GAS v4u*)(XN + (size_t)tok * D + 512 + 8 * F.lane);
            float xf[16];
#pragma unroll
            for (int e = 0; e < 4; ++e) { xf[2 * e] = bflo(xa[e]); xf[2 * e + 1] = bfhi(xa[e]); xf[8 + 2 * e] = bflo(xb[e]); xf[9 + 2 * e] = bfhi(xb[e]); }
            LDS_WAIT(); asm volatile("" ::: "memory");
            for (int base = 0; base < n; base += 64) {
                float res = 0.f; const int lim = (n - base) < 64 ? (n - base) : 64;
                for (int q = 0; q < lim; q += 4) {
                    v4u ra[4], rb[4];
#pragma unroll
                    for (int u = 0; u < 4; ++u) { const int qq = (q + u) < lim ? (q + u) : (lim - 1); const int ex = __builtin_amdgcn_readfirstlane(LST[2 * (base + qq)]);
                        const bf16* row = U + (size_t)ex * D; ra[u] = *(const GAS v4u*)(row + 8 * F.lane); rb[u] = *(const GAS v4u*)(row + 512 + 8 * F.lane); }
#pragma unroll
                    for (int u = 0; u < 4; ++u) { float a = 0.f;
#pragma unroll
                        for (int e = 0; e < 4; ++e) { a += xf[2 * e] * bflo(ra[u][e]) + xf[2 * e + 1] * bfhi(ra[u][e]); a += xf[8 + 2 * e] * bflo(rb[u][e]) + xf[9 + 2 * e] * bfhi(rb[u][e]); }
                        a = wave_sum(a); if (F.lane == q + u) res = a; }
                }
                if (F.lane < lim) { const int pi = LST[2 * (base + F.lane) + 1]; const float g = GATE[(size_t)tok * 128 + pi];
                    HID[(size_t)tok * 128 + pi] = 0.5f * res * (1.f + erff(res * 0.70710678118654752f)) * g; }
            }
            LDS_WAIT(); asm volatile("" ::: "memory");
        }
    }
}
__device__ __forceinline__ void peer_e2(Frame& F) {
    const bf16* VS = (const bf16*)(F.ws + WS_VS); const int* IDX = (const int*)(F.ws + WS_IDX); const float* HID = (const float*)(F.ws + WS_HID);
    const float* H = (const float*)(F.ws + WS_H); float* SS2 = (float*)(F.ctl + CW_SS2);
    const int gq = F.lane >> 4, c = F.lane & 15;
    for (int item = blockIdx.x; item < 8 * (T / 32); item += F.G) {
        const int slice = item & 7, tile = item >> 3;
        const bf16* vs = VS + (size_t)slice * 16384 * 128 + 8 * c;
        for (int tt = 0; tt < 4; ++tt) {
            const int tok = tile * 32 + F.wave * 4 + tt;
            const int idA = IDX[(size_t)tok * 128 + F.lane], idB = IDX[(size_t)tok * 128 + 64 + F.lane];
            const float hA = HID[(size_t)tok * 128 + F.lane], hB = HID[(size_t)tok * 128 + 64 + F.lane];
            float acc[8];
#pragma unroll
            for (int e = 0; e < 8; ++e) acc[e] = 0.f;
#pragma unroll
            for (int s8 = 0; s8 < 32; s8 += 8) {
                v4u rv[8]; float hd[8];
#pragma unroll
                for (int u = 0; u < 8; ++u) { const int s = s8 + u; const int src = (4 * s + gq) & 63; const int ex = __shfl(s < 16 ? idA : idB, src); hd[u] = __shfl(s < 16 ? hA : hB, src);
                    rv[u] = *(const GAS v4u*)(vs + (size_t)ex * 128); }
#pragma unroll
                for (int u = 0; u < 8; ++u)
#pragma unroll
                    for (int e = 0; e < 4; ++e) { acc[2 * e] += hd[u] * bflo(rv[u][e]); acc[2 * e + 1] += hd[u] * bfhi(rv[u][e]); }
            }
#pragma unroll
            for (int e = 0; e < 8; ++e) { acc[e] += __shfl_xor(acc[e], 16); acc[e] += __shfl_xor(acc[e], 32); }
            float ss = 0.f;
            if (gq == 0) { const size_t o = (size_t)tok * D + slice * 128 + 8 * c; const f32x4 h0 = *(const GAS f32x4*)(H + o), h1 = *(const GAS f32x4*)(H + o + 4);
#if DBG == 1
#pragma unroll
                for (int e = 0; e < 8; ++e) acc[e] = 0.f;
#endif
#if DBG == 5
#pragma unroll
                for (int e = 0; e < 8; ++e) acc[e] = -acc[e];
#endif
                f32x4 o0 = h0 + (f32x4){acc[0], acc[1], acc[2], acc[3]}, o1 = h1 + (f32x4){acc[4], acc[5], acc[6], acc[7]};
                *(GAS f32x4*)(F.out + o) = o0; *(GAS f32x4*)(F.out + o + 4) = o1;
                ss = (o0.x * o0.x + o0.y * o0.y) + (o0.z * o0.z + o0.w * o0.w) + (o1.x * o1.x + o1.y * o1.y) + (o1.z * o1.z + o1.w * o1.w); }
#pragma unroll
            for (int o2 = 1; o2 < 16; o2 <<= 1) ss += __shfl_xor(ss, o2);
            if (F.lane == 0) atomicAdd(SS2 + tok, ss);
        }
    }
}
__device__ __forceinline__ void final_norm(Frame& F) {
    const int gw = F.vcu * NWAVES + F.wave, NGW = F.G * NWAVES; const float* SS2 = (const float*)(F.ctl + CW_SS2);
    const float dg = 1.f + fminf(__hip_atomic_load((const float*)(F.ctl + 2048), RLX_AGENT), 10.f);
    for (int m = gw; m < T; m += NGW) { const float rstd = dg / sqrtf(__hip_atomic_load(SS2 + m, RLX_AGENT) * (1.f / D) + EPS);
        GAS f32x4* p = (GAS f32x4*)(F.out + (size_t)m * D) + F.lane;
#pragma unroll
        for (int j = 0; j < 4; ++j) { const f32x4 w = *((const GAS f32x4*)F.A->in[17] + F.lane + 64 * j); p[64 * j] = p[64 * j] * rstd * w; } }
}

#if DBG == 6
__device__ __forceinline__ void peer_check(Frame& F) {
    if (blockIdx.x != 0 || F.wave >= 4) return;
    const int toks[4] = {5, 4101, 9000, 16000}; const int tok = toks[F.wave];
    const bf16* XN = (const bf16*)(F.ws + WS_HN); const int* IDX = (const int*)(F.ws + WS_IDX); const float* GATE = (const float*)(F.ws + WS_GATE); const float* H = (const float*)(F.ws + WS_H);
    float xf[16], o[16];
#pragma unroll
    for (int e = 0; e < 16; ++e) { xf[e] = bf1(XN[(size_t)tok * D + 64 * e + F.lane]); o[e] = 0.f; }
    for (int i = 0; i < 128; ++i) { const int ex = IDX[(size_t)tok * 128 + i]; float a = 0.f;
#pragma unroll
        for (int e = 0; e < 16; ++e) a += xf[e] * F.A->in[15][(size_t)ex * D + 64 * e + F.lane];
        a = wave_sum(a); const float hd = 0.5f * a * (1.f + erff(a * 0.70710678118654752f)) * GATE[(size_t)tok * 128 + i];
#pragma unroll
        for (int e = 0; e < 16; ++e) o[e] += hd * F.A->in[16][(size_t)ex * D + 64 * e + F.lane]; }
    float num = 0.f, den = 0.f;
#pragma unroll
    for (int e = 0; e < 16; ++e) { const float mine = F.out[(size_t)tok * D + 64 * e + F.lane] - H[(size_t)tok * D + 64 * e + F.lane]; num += (mine - o[e]) * (mine - o[e]); den += o[e] * o[e]; }
    num = wave_sum(num); den = wave_sum(den);
    if (F.lane == 0) atomicAdd((float*)(F.ctl + 2048) , sqrtf(num / den) * 0.25f);
}
#endif

#if DBG == 7
__device__ __forceinline__ void topk_check(Frame& F) {
    if (blockIdx.x != 0 || F.wave >= 4) return;
    const int toks[4] = {5, 4101, 9000, 16000}; const int hs[4] = {0, 3, 5, 7}; const int tok = toks[F.wave], hh = hs[F.wave];
    const bf16* Q = (const bf16*)F.out; const bf16* KEYS = (const bf16*)(F.ws + WS_KEYS); const int* IDX = (const int*)(F.ws + WS_IDX); const float* GATE = (const float*)(F.ws + WS_GATE);
    LAS float* S = (LAS float*)(F.lds + 4096 * F.wave);
    for (int p = 0; p < 2; ++p) for (int r = 0; r < 2; ++r) { const int n = F.lane + 64 * r; float a = 0.f;
        for (int d = 0; d < 128; ++d) a += bf1(Q[(size_t)tok * 2048 + hh * 256 + p * 128 + d]) * bf1(KEYS[((size_t)(hh * 2 + p) * 128 + n) * 128 + d]);
        S[p * 128 + n] = a; }
    LDS_WAIT(); asm volatile("" ::: "memory");
    float cmin = 1e30f, cmax = -1e30f; float cs[16];
    for (int i = 0; i < 16; ++i) { const int ex = IDX[(size_t)tok * 128 + hh * 16 + i]; cs[i] = S[ex >> 7] + S[128 + (ex & 127)]; cmin = fminf(cmin, cs[i]); cmax = fmaxf(cmax, cs[i]); }
    float den = 0.f; for (int i = 0; i < 16; ++i) den += __expf(cs[i] - cmax);
    float gerr = 0.f; for (int i = 0; i < 16; ++i) gerr = fmaxf(gerr, fabsf(__expf(cs[i] - cmax) / den - GATE[(size_t)tok * 128 + hh * 16 + i]));
    int cnt = 0;
    for (int i = 0; i < 128; ++i) for (int r = 0; r < 2; ++r) cnt += (S[i] + S[128 + F.lane + 64 * r] > cmin + 1e-4f) ? 1 : 0;
    const float tot = wave_sum((float)cnt);
    if (F.lane == 0) atomicAdd((float*)(F.ctl + 2048), 0.25f * (fminf(fabsf(tot - 15.f), 16.f) / 16.f + 10.f * gerr));
}
#endif

#if DBG == 10
__device__ __forceinline__ void topk_check(Frame& F) {
    if (blockIdx.x != 0 || F.wave >= 1) return;
    const bf16* Q = (const bf16*)F.out; const bf16* KEYS = (const bf16*)(F.ws + WS_KEYS); LAS float* SCR = (LAS float*)F.lds;
    const int hi = F.lane >> 5, tok = F.lane & 31;
    f32x16 acc[4];
#pragma unroll
    for (int rt = 0; rt < 4; ++rt)
#pragma unroll
        for (int e = 0; e < 16; ++e) acc[rt][e] = 0.f;
#pragma unroll 1
    for (int ks = 0; ks < 8; ++ks) { const bf16x8 bq = *(const GAS bf16x8*)(Q + (size_t)tok * 2048 + 16 * ks + 8 * hi);
#pragma unroll
        for (int rt = 0; rt < 4; ++rt) { const bf16x8 ak = *(const GAS bf16x8*)(KEYS + ((size_t)(32 * rt + (F.lane & 31))) * 128 + 16 * ks + 8 * hi);
            acc[rt] = __builtin_amdgcn_mfma_f32_32x32x16_bf16(ak, bq, acc[rt], 0, 0, 0); } }
#pragma unroll
    for (int rt = 0; rt < 4; ++rt)
#pragma unroll
        for (int e = 0; e < 16; ++e) SCR[(F.lane & 31) * 128 + 32 * rt + (e & 3) + 8 * (e >> 2) + 4 * hi] = acc[rt][e];
    LDS_WAIT(); asm volatile("" ::: "memory");
    float num = 0.f, den = 0.f;
    for (int tk = 0; tk < 32; tk += 5) for (int r = 0; r < 2; ++r) { const int n = F.lane + 64 * r; float a = 0.f;
        for (int d = 0; d < 128; ++d) a += bf1(Q[(size_t)tk * 2048 + d]) * bf1(KEYS[(size_t)n * 128 + d]);
        const float m = SCR[tk * 128 + n]; num += (m - a) * (m - a); den += a * a; }
    num = wave_sum(num); den = wave_sum(den);
    if (F.lane == 0) atomicAdd((float*)(F.ctl + 2048), sqrtf(num / den));
}
#endif

#if DBG == 11
__device__ __forceinline__ void topk_check(Frame& F) {
    if (blockIdx.x != 0 || F.wave >= 1) return;
    const bf16* Q = (const bf16*)F.out; const bf16* KEYS = (const bf16*)(F.ws + WS_KEYS); const int* IDX = (const int*)(F.ws + WS_IDX);
    int* IDX2 = (int*)(F.ws + WS_HID); float* GATE2 = (float*)(F.ws + WS_HID + 4 * MiB);
    LAS float* S = (LAS float*)F.lds;
    const int hi = F.lane >> 5, tok = F.lane & 31;
    for (int p = 0; p < 2; ++p) for (int j = 0; j < 64; ++j) { const int n = 64 * hi + j; float a = 0.f;
        for (int d = 0; d < 128; ++d) a += bf1(Q[(size_t)tok * 2048 + p * 128 + d]) * bf1(KEYS[((size_t)p * 128 + n) * 128 + d]);
        S[(tok * 2 + p) * 128 + n] = a + (DBGV == 3 ? 8.0f : 0.f); }
    LDS_WAIT(); asm volatile("" ::: "memory");
    float ab[2][16];
#pragma unroll
    for (int p = 0; p < 2; ++p) { f32x16 acc[4];
#pragma unroll
        for (int rt = 0; rt < 4; ++rt)
#pragma unroll
            for (int e = 0; e < 16; ++e) acc[rt][e] = S[(tok * 2 + p) * 128 + 32 * rt + (e & 3) + 8 * (e >> 2) + 4 * hi];
#if DBGV == 1
        {
            float prev = 3.0e38f;
#pragma unroll
            for (int r = 0; r < 16; ++r) { float best = -3.0e38f;
#pragma unroll 1
                for (int n = 0; n < 128; ++n) { const float v = __builtin_bit_cast(float, (__builtin_bit_cast(unsigned, S[(tok * 2 + p) * 128 + n]) & ~0x7Fu) | (unsigned)n); if (v < prev && v > best) best = v; }
                ab[p][r] = best; prev = best; }
        }
#elif DBGV == 2 || DBGV == 3
        {   float la[16], lb[16];
            top16_of_acc<false>(acc, hi, la);
#pragma unroll
            for (int rt = 0; rt < 4; ++rt)
#pragma unroll
                for (int e = 0; e < 16; ++e) acc[rt][e] = S[(tok * 2 + p) * 128 + 32 * rt + (e & 3) + 8 * (e >> 2) + 4 * (1 - hi)];
            top16_of_acc<false>(acc, 1 - hi, lb);
            top16_merge(la, lb);
#pragma unroll
            for (int e = 0; e < 16; ++e) ab[p][e] = la[e]; }
#else
        top16_of_acc(acc, hi, ab[p]);
#endif
    }
    emit_topk(ab, hi, IDX2, GATE2, (size_t)tok, 0);
    asm volatile("s_waitcnt vmcnt(0)" ::: "memory"); __builtin_amdgcn_fence(__ATOMIC_ACQ_REL, "agent");
    float d1 = 0.f, d2 = 0.f;
    if (hi == 0) {
#pragma unroll 1
        for (int i = 0; i < 16; ++i) { const int ex = __hip_atomic_load(IDX2 + (size_t)tok * 128 + i, RLX_AGENT); bool f = false;
#pragma unroll 1
            for (int j = 0; j < 16; ++j) f |= (IDX[(size_t)tok * 128 + j] == ex); d1 += f ? 0.f : 1.f; }
        float cmin = 1e30f;
#pragma unroll 1
        for (int i = 0; i < 16; ++i) { const int ex = __hip_atomic_load(IDX2 + (size_t)tok * 128 + i, RLX_AGENT); cmin = fminf(cmin, S[(tok * 2) * 128 + (ex >> 7)] + S[(tok * 2 + 1) * 128 + (ex & 127)]); }
        int cnt = 0;
#pragma unroll 1
        for (int i = 0; i < 128; ++i)
#pragma unroll 4
            for (int j = 0; j < 128; ++j) cnt += (S[(tok * 2) * 128 + i] + S[(tok * 2 + 1) * 128 + j] > cmin + 1e-4f) ? 1 : 0;
        d2 = fminf(fabsf((float)cnt - 15.f), 16.f);
    }
    d1 = wave_sum(d1) / 512.f; d2 = wave_sum(d2) / 512.f;
    if (F.lane == 0) atomicAdd((float*)(F.ctl + 2048), d1 + 4.f * d2);
}
#endif

__global__ void __launch_bounds__(NTHR, 2) mk_fwd(Args args) {
    extern __shared__ __attribute__((aligned(16))) unsigned char lds[];
    Frame F;
    F.lds = (LAS unsigned char*)lds;
    F.MISC = (volatile LAS unsigned*)(F.lds + MISC_OFF);
    F.tid = threadIdx.x; F.lane = F.tid & 63; F.wave = __builtin_amdgcn_readfirstlane(F.tid >> 6);
    F.G = gridDim.x; { const int bx = blockIdx.x; F.vcu = (F.G % 8 == 0) ? (bx % 8) * (F.G / 8) + bx / 8 : bx; }
    F.ws = args.ws; F.ctl = (gu32*)(args.ws + WS_CTL); F.out = args.out;
    F.A = &args;
    for (int u = F.tid; u < (LDS_BYTES - RING_BYTES) / 4; u += NTHR) ((LAS unsigned*)(F.lds + RING_BYTES))[u] = 0u;
    __syncthreads();
    XcdBarrier bar; bar.bar = (unsigned*)(F.ctl + CW_BAR); bar.x = 0; bar.st = nullptr;
    if (!MK_PER_PHASE) bar = xcd_barrier_post((unsigned*)(F.ctl + CW_BAR), F.MISC + 8);
    const int lo = args.ph_lo, hi = args.ph_hi;
#ifndef PH_MASK
#define PH_MASK 0xFFFF
#endif
#define IN(k) (((PH_MASK >> (k)) & 1) && lo <= (k) && (k) < hi)
#define SEAM(k) do { if (IN(k) && IN((k) + 1)) xcd_barrier(bar); } while (0)
    bf16* HN = (bf16*)(F.ws + WS_HN); bf16* PROJ = (bf16*)(F.ws + WS_PROJ); bf16* WIN = (bf16*)(F.ws + WS_WIN);

    if (IN(0)) { p0_prologue(F); } SEAM(0);
    if (IN(1)) {
        pg8::Gemm g{HN, WIN, T, NA, D}; pg8::StaticOrder S; S.init(T, NA, F.G, (int)blockIdx.x);
        pg8::EpiBf16<0> E{PROJ, NA, nullptr, 0, 0, 1.f};
        pg8::gemm_phase<pg8::EpiBf16<0>, pg8::StaticOrder, true, true>(F.lds, g, S, E);
    } SEAM(1);
    if (IN(2)) { ssd_pass_a(F); } SEAM(2);
    if (IN(3)) { ssd_scan(F); } SEAM(3);
    if (IN(4)) { ssd_pass_b(F); } SEAM(4);
    if (IN(5)) {
        ssd_norm(F);
        pg8::Gemm g{HN, WIN + (size_t)NA * D, T, NB_, D}; pg8::StaticOrder S; S.init(T, NB_, F.G, (int)blockIdx.x);
        EpiG1b E{PROJ, F.A->in[9]};
        pg8::gemm_phase<EpiG1b, pg8::StaticOrder, true, true>(F.lds, g, S, E);
    } SEAM(5);
    if (IN(6)) { hg_pass<false>(F); } SEAM(6);
    if (IN(7)) { hg_scan(F); } SEAM(7);
    if (IN(8)) { hg_pass<true>(F); } SEAM(8);
    if (IN(9)) {
        pg8::Gemm g{(const bf16*)F.out, (const bf16*)(F.ws + WS_WOUT), T, D, 2048}; pg8::StaticOrder S; S.init(T, D, F.G, (int)blockIdx.x);
        EpiRes E{F.A->in[0], (float*)(F.ws + WS_H)};
        pg8::gemm_phase<EpiRes, pg8::StaticOrder, true, true>(F.lds, g, S, E);
    } SEAM(9);
    if (IN(10)) { peer_prep(F); } SEAM(10);
    if (IN(11)) {
        pg8::Gemm g{HN, (const bf16*)(F.ws + WS_WQ), T, 2048, D}; pg8::StaticOrder S; S.init(T, 2048, F.G, (int)blockIdx.x);
        pg8::EpiBf16<0> E{(bf16*)F.out, 2048, nullptr, 0, 0, 1.f};
        pg8::gemm_phase<pg8::EpiBf16<0>, pg8::StaticOrder, true, true>(F.lds, g, S, E);
    } SEAM(11);
    if (IN(12)) { peer_topk(F); } SEAM(12);
    if (IN(13)) { peer_e1(F); } SEAM(13);
    if (IN(14)) { peer_e2(F); } SEAM(14);
#if DBG == 7 || DBG == 10 || DBG == 11
    if (lo == 100) { topk_check(F); return; }
#endif
#if DBG == 6
    if (lo == 15) { peer_check(F); return; }
    if (lo == 16) { final_norm(F); return; }
#endif
    if (IN(15)) { final_norm(F); }
#undef IN
#undef SEAM
}

extern "C" void kernel_launch(void* const* d_in, const int* in_sizes, int n_in, void* d_out, int out_size, void* d_ws, size_t ws_size, hipStream_t stream) {
    static int grid = 0;
    if (grid == 0) {
        if (n_in != 18 || out_size != T * D || ws_size < WS_END) { fprintf(stderr, "kernel_launch: unexpected shapes (n_in %d, out %d, ws %zu)\n", n_in, out_size, ws_size); grid = -1; return; }
        int dev = 0, cus = 0, per_cu = 0;
        if (hipGetDevice(&dev) != hipSuccess || hipDeviceGetAttribute(&cus, hipDeviceAttributeMultiprocessorCount, dev) != hipSuccess) { grid = -1; return; }
        if (hipFuncSetAttribute((const void*)mk_fwd, hipFuncAttributeMaxDynamicSharedMemorySize, LDS_BYTES) != hipSuccess) { fprintf(stderr, "kernel_launch: hipFuncSetAttribute failed\n"); grid = -1; return; }
        if (hipOccupancyMaxActiveBlocksPerMultiprocessor(&per_cu, (const void*)mk_fwd, NTHR, LDS_BYTES) != hipSuccess || per_cu < 1) { fprintf(stderr, "kernel_launch: occupancy query says %d blocks per CU\n", per_cu); grid = -1; (void)hipGetLastError(); return; }
        (void)hipGetLastError();
        grid = cus;
    }
    if (grid < 0) return;
    (void)hipMemsetAsync((char*)d_ws + WS_CTL, 0, CTL_ZERO_BYTES, stream);
    Args a{};
    for (int i = 0; i < 18; ++i) a.in[i] = (const float*)d_in[i];
    a.out = (float*)d_out; a.ws = (unsigned char*)d_ws;
#if MK_PER_PHASE
    for (int p = 0; p < NPH + (DBG == 6); ++p) { a.ph_lo = p; a.ph_hi = p + 1; hipLaunchKernelGGL(mk_fwd, dim3(grid), dim3(NTHR), LDS_BYTES, stream, a);
        if ((DBG == 7 || DBG == 10 || DBG == 11) && p == 12) { a.ph_lo = 100; a.ph_hi = 101; hipLaunchKernelGGL(mk_fwd, dim3(grid), dim3(NTHR), LDS_BYTES, stream, a); } }
#else
    a.ph_lo = 0; a.ph_hi = NPH; hipLaunchKernelGGL(mk_fwd, dim3(grid), dim3(NTHR), LDS_BYTES, stream, a);
#endif
}
```

```cpp
#include <hip/hip_runtime.h>
#include <cstdio>
#include <cstdint>
namespace pg8 {
#define PG8_LAS __attribute__((address_space(3)))
typedef unsigned short bf16_t;
typedef short bf16x8 __attribute__((ext_vector_type(8)));
typedef float f32x4 __attribute__((ext_vector_type(4)));
typedef unsigned u32x4 __attribute__((ext_vector_type(4)));
constexpr int BM = 256, BK = 64, HALF = 128, HTB = HALF * BK * 2  , STAGE_BYTES = 8 * HTB, NXCD = 8, WGM = 8;

__host__ __device__ __forceinline__ int lds_byte(int r, int c) { const int st = (r >> 4) * 2 + (c >> 5), rr = r & 15, cc = c & 31, ob = rr * 64 + cc * 2; return st * 1024 + (ob ^ (((ob >> 9) & 1) << 5)); }
__host__ __device__ __forceinline__ void stage_rc(int b, int& R, int& C) { const int st = b / 1024, sb = b % 1024, swz = sb ^ (((sb >> 9) & 1) << 5); R = (st >> 1) * 16 + swz / 64; C = (st & 1) * 32 + (swz % 64) / 2; }
__host__ __device__ __forceinline__ int perm32(int rho) { const int n = rho >> 4, i = rho & 15; return 8 * (i >> 2) + 4 * n + (i & 3); }

struct Unit { int pm, pn; };
struct Gemm { const bf16_t* A; const bf16_t* Bt; int M, N, K; };

struct StaticOrder {
    int nM, nN, nwg, G, c;
    __host__ __device__ void init(int M, int N, int G_, int c_) { nM = M / BM; nN = N / BM; nwg = nM * nN; G = G_; c = c_; }
    __host__ __device__ bool next(int i, Unit& u) const {
        const long L = (long)i * G + c; if (L >= nwg) return false;
        int wgid = (int)L; { const int q = nwg / NXCD, r = nwg % NXCD, xcd = wgid % NXCD, off = wgid / NXCD; wgid = (xcd < r ? xcd * (q + 1) : r * (q + 1) + (xcd - r) * q) + off; }
        const int nig = WGM * nN, gid = wgid / nig, fm = gid * WGM, gsz = (nM - fm) < WGM ? (nM - fm) : WGM;
        u.pm = fm + ((wgid % nig) % gsz); u.pn = (wgid % nig) / gsz; return true;
    }
    __device__ __forceinline__ void a_ready(const Unit&) const {}
    __device__ __forceinline__ void done(const Unit&) const {}
};

__device__ __forceinline__ unsigned cvt_pk_bf16(float lo, float hi) { unsigned r; asm volatile("v_cvt_pk_bf16_f32 %0, %1, %2" : "=v"(r) : "v"(lo), "v"(hi)); return r; }
typedef float f32x2 __attribute__((ext_vector_type(2)));
__device__ __forceinline__ f32x2 gelu_pk(f32x2 v) {
    const f32x2 av = __builtin_elementwise_abs(v), d = av * 0.2316418882f + 1.0f;
    f32x2 t; t.x = __builtin_amdgcn_rcpf(d.x); t.y = __builtin_amdgcn_rcpf(d.y);
    f32x2 q = t * 0.5307027145f + (-0.7265760135f); q = q * t + 0.7107068705f; q = q * t + (-0.142248368f); q = q * t + 0.127414796f; q = q * t;
    const f32x2 s = (v * v) * (-0.72134752044f);
    f32x2 e; e.x = __builtin_amdgcn_exp2f(s.x); e.y = __builtin_amdgcn_exp2f(s.y);
    const f32x2 m = v * (q * e), r = v - m;
    f32x2 o; o.x = v.x < 0.f ? m.x : r.x; o.y = v.y < 0.f ? m.y : r.y; return o;
}

template <int ACT  > struct EpiBf16 {
    static constexpr bool PERM = true, AFTER_DRAIN = false; static_assert(ACT == 0 || ACT == 1, "EpiBf16: ACT is 0 (none) or 1 (gelu_pk)");
    bf16_t* O; int ldc; const float* bias; int split_cols; size_t split_stride; float scale0;
    __device__ __forceinline__ void operator()(const f32x4 (&acc)[2][2][4][2], const Unit& u, int wr, int wc, int fr, int fq) const {
        const int row0 = u.pm * BM + wr * 64 + fr; int colt = u.pn * BM; bf16_t* base = O;
        float sc = 1.f; if (split_cols) { const int t = colt / split_cols; base += (size_t)t * split_stride; colt -= t * split_cols; if (t == 0) sc = scale0; }
        const int col0 = colt + wc * 32 + 8 * fq, bcol0 = u.pn * BM + wc * 32 + 8 * fq;
        f32x4 bv[2][2];
#pragma unroll
        for (int bj = 0; bj < 2; ++bj)
#pragma unroll
            for (int n = 0; n < 2; ++n) bv[bj][n] = bias ? *(const f32x4*)(bias + bcol0 + bj * HALF + 4 * n) : (f32x4){0.f, 0.f, 0.f, 0.f};
#pragma unroll
        for (int ai = 0; ai < 2; ++ai)
#pragma unroll
            for (int m = 0; m < 4; ++m) { bf16_t* rowp = base + (size_t)(row0 + ai * HALF + m * 16) * ldc + col0;
#pragma unroll
                for (int bj = 0; bj < 2; ++bj) { f32x4 v0 = acc[ai][bj][m][0] + bv[bj][0], v1 = acc[ai][bj][m][1] + bv[bj][1];
                    if (ACT == 1) { f32x2 a = gelu_pk((f32x2){v0[0], v0[1]}), b = gelu_pk((f32x2){v0[2], v0[3]}), c = gelu_pk((f32x2){v1[0], v1[1]}), d = gelu_pk((f32x2){v1[2], v1[3]});
                        v0 = (f32x4){a.x, a.y, b.x, b.y}; v1 = (f32x4){c.x, c.y, d.x, d.y}; }
                    v0 = v0 * sc; v1 = v1 * sc; u32x4 w; w.x = cvt_pk_bf16(v0[0], v0[1]); w.y = cvt_pk_bf16(v0[2], v0[3]); w.z = cvt_pk_bf16(v1[0], v1[1]); w.w = cvt_pk_bf16(v1[2], v1[3]);
                    *(u32x4*)(rowp + bj * HALF) = w; } }
    }
};
template <class Epi, class Sched, bool ALIGN_EPI = false, bool SP2 = false>
__device__ __forceinline__ void gemm_phase(PG8_LAS unsigned char* lds, const Gemm g, const Sched& S, const Epi& E) {
    int tid_ = threadIdx.x; asm volatile("" : "+v"(tid_));
    const int tid = tid_, wid = __builtin_amdgcn_readfirstlane(tid >> 6), lane = tid & 63, wr = wid >> 2, wc = wid & 3, fr = lane & 15, fq = lane >> 4;
    const int K = g.K, nt = K / BK;
    unsigned voffA[2], voffB[2];
#pragma unroll
    for (int i = 0; i < 2; ++i) { int R, C; stage_rc(tid * 16 + i * 8192, R, C); const int Rb = Epi::PERM ? ((R & ~31) + perm32(R & 31)) : R;
        voffA[i] = (unsigned)(R * K + C) * 2u; voffB[i] = (unsigned)(Rb * K + C) * 2u; }
    const size_t kstep = (size_t)(BK * 2);
    const size_t hstep = (size_t)HALF * K * 2;
    const size_t tstep = 2 * hstep;
    const unsigned ldsw = (unsigned)wid * 1024u;
    const int aoff = lds_byte(wr * 64 + fr, fq * 8), boff = lds_byte(wc * 32 + fr, fq * 8);
#define PG8_SA(b, h) (((b) * 2 + (h)) * HTB)
#define PG8_SB(b, h) ((4 + (b) * 2 + (h)) * HTB)
#define PG8_STAGE(bufoff, gbase, voff) do { _Pragma("unroll") for (int _i = 0; _i < 2; ++_i) \
        __builtin_amdgcn_global_load_lds((const unsigned*)((const char*)(gbase) + (voff)[_i]), (PG8_LAS unsigned*)(lds + (bufoff) + ldsw + _i * 8192), 16, 0, 0); } while (0)
#define PG8_LDA(dst, b, h) do { _Pragma("unroll") for (int m = 0; m < 4; ++m) _Pragma("unroll") for (int k = 0; k < 2; ++k) dst[m][k] = *(const PG8_LAS bf16x8*)(lds + PG8_SA(b, h) + aoff + m * 2048 + k * 1024); } while (0)
#define PG8_LDB(dst, b, h) do { _Pragma("unroll") for (int n = 0; n < 2; ++n) _Pragma("unroll") for (int k = 0; k < 2; ++k) dst[n][k] = *(const PG8_LAS bf16x8*)(lds + PG8_SB(b, h) + boff + n * 2048 + k * 1024); } while (0)
#define PG8_MMA(ai, bj, At, Bt) do { __builtin_amdgcn_s_setprio(1); _Pragma("unroll") for (int m = 0; m < 4; ++m) _Pragma("unroll") for (int n = 0; n < 2; ++n) _Pragma("unroll") for (int k = 0; k < 2; ++k) \
        acc[ai][bj][m][n] = __builtin_amdgcn_mfma_f32_16x16x32_bf16(Bt[n][k], At[m][k], acc[ai][bj][m][n], 0, 0, 0); __builtin_amdgcn_s_setprio(0); } while (0)
#define PG8_WAIT_V(n) asm volatile("s_waitcnt vmcnt(" #n ")" ::: "memory")
#define PG8_WAIT_L(n) asm volatile("s_waitcnt lgkmcnt(" #n ")" ::: "memory")
#define PG8_BAR __builtin_amdgcn_s_barrier()
#define PG8_SCHED __builtin_amdgcn_sched_barrier(0)
    Unit cur, nxt; int ui = 0;
    if (!S.next(0, cur)) return;
    f32x4 acc[2][2][4][2];
#pragma unroll
    for (int a = 0; a < 2; ++a)
#pragma unroll
        for (int b = 0; b < 2; ++b)
#pragma unroll
            for (int m = 0; m < 4; ++m)
#pragma unroll
                for (int n = 0; n < 2; ++n) acc[a][b][m][n] = (f32x4){0.f, 0.f, 0.f, 0.f};
    bf16x8 At[4][2], B0[2][2], B1[2][2];
    const char* cA = (const char*)g.A + (size_t)cur.pm * tstep; const char* cB = (const char*)g.Bt + (size_t)cur.pn * tstep;
    S.a_ready(cur);
    if constexpr (SP2) {
        PG8_STAGE(PG8_SB(0, 0), cB, voffB); PG8_STAGE(PG8_SB(0, 1), cB + hstep, voffB); PG8_STAGE(PG8_SA(0, 0), cA, voffA); PG8_STAGE(PG8_SA(0, 1), cA + hstep, voffA);
        if (wr == 1) PG8_BAR;
        PG8_WAIT_V(2); PG8_BAR;
        PG8_STAGE(PG8_SB(1, 0), cB + kstep, voffB); PG8_STAGE(PG8_SA(1, 0), cA + kstep, voffA); PG8_STAGE(PG8_SB(1, 1), cB + hstep + kstep, voffB);
        PG8_WAIT_V(6); PG8_BAR;
    } else {
        PG8_STAGE(PG8_SB(0, 0), cB, voffB); PG8_STAGE(PG8_SA(0, 0), cA, voffA); PG8_STAGE(PG8_SB(0, 1), cB + hstep, voffB); PG8_STAGE(PG8_SA(0, 1), cA + hstep, voffA);
        if (wr == 1) PG8_BAR;
        PG8_WAIT_V(4); PG8_BAR;
        PG8_STAGE(PG8_SB(1, 0), cB + kstep, voffB); PG8_STAGE(PG8_SA(1, 0), cA + kstep, voffA); PG8_STAGE(PG8_SB(1, 1), cB + hstep + kstep, voffB);
        PG8_WAIT_V(6); PG8_BAR;
    }
    for (;;) {
        const bool has_next = S.next(ui + 1, nxt);
        const char* nA = has_next ? (const char*)g.A + (size_t)nxt.pm * tstep : cA; const char* nB = has_next ? (const char*)g.Bt + (size_t)nxt.pn * tstep : cB;
        for (int t = 0; t < nt; t += 2) {
            const bool last = (t == nt - 2);
            const char* a1 = cA + (size_t)(t + 1) * kstep;
            const char* a2 = last ? nA : cA + (size_t)(t + 2) * kstep; const char* b2 = last ? nB : cB + (size_t)(t + 2) * kstep;
            const char* a3 = a2 + kstep; const char* b3 = b2 + kstep;
            if (last && has_next) S.a_ready(nxt);
            if constexpr (SP2) {
            PG8_LDB(B0, 0, 0); PG8_LDB(B1, 0, 1); PG8_SCHED; PG8_LDA(At, 0, 0); PG8_STAGE(PG8_SA(1, 1), a1 + hstep, voffA);
            PG8_WAIT_V(8); PG8_WAIT_L(0); PG8_BAR; PG8_MMA(0, 0, At, B0); PG8_MMA(0, 1, At, B1); PG8_BAR; PG8_SCHED;
            PG8_LDA(At, 0, 1); PG8_STAGE(PG8_SB(0, 0), b2, voffB); PG8_STAGE(PG8_SB(0, 1), b2 + hstep, voffB); PG8_STAGE(PG8_SA(0, 0), a2, voffA);
            PG8_WAIT_V(8); PG8_WAIT_L(0); PG8_BAR; PG8_MMA(1, 0, At, B0); PG8_MMA(1, 1, At, B1); PG8_BAR; PG8_SCHED;
            PG8_LDB(B0, 1, 0); PG8_LDB(B1, 1, 1); PG8_SCHED; PG8_LDA(At, 1, 0); PG8_STAGE(PG8_SA(0, 1), a2 + hstep, voffA);
            PG8_WAIT_V(8); PG8_WAIT_L(0); PG8_BAR; PG8_MMA(0, 0, At, B0); PG8_MMA(0, 1, At, B1); PG8_BAR; PG8_SCHED;
            PG8_LDA(At, 1, 1); PG8_STAGE(PG8_SB(1, 0), b3, voffB); PG8_STAGE(PG8_SB(1, 1), b3 + hstep, voffB); PG8_STAGE(PG8_SA(1, 0), a3, voffA);
            PG8_WAIT_V(8); PG8_WAIT_L(0); PG8_BAR; PG8_MMA(1, 0, At, B0); PG8_MMA(1, 1, At, B1); PG8_BAR; PG8_SCHED;
            } else {
            PG8_LDB(B0, 0, 0); PG8_SCHED; PG8_LDA(At, 0, 0); PG8_STAGE(PG8_SA(1, 1), a1 + hstep, voffA);
            PG8_WAIT_L(8); PG8_BAR; PG8_WAIT_L(0); PG8_MMA(0, 0, At, B0); PG8_BAR; PG8_SCHED;
            PG8_LDB(B1, 0, 1); PG8_STAGE(PG8_SB(0, 0), b2, voffB);
            PG8_BAR; PG8_WAIT_L(0); PG8_MMA(0, 1, At, B1); PG8_BAR;
            PG8_LDA(At, 0, 1); PG8_STAGE(PG8_SA(0, 0), a2, voffA);
            PG8_BAR; PG8_WAIT_L(0); PG8_MMA(1, 0, At, B0); PG8_BAR; PG8_SCHED;
            PG8_STAGE(PG8_SB(0, 1), b2 + hstep, voffB);
            PG8_WAIT_V(6); PG8_BAR; PG8_MMA(1, 1, At, B1); PG8_BAR;
            PG8_LDB(B0, 1, 0); PG8_SCHED; PG8_LDA(At, 1, 0); PG8_STAGE(PG8_SA(0, 1), a2 + hstep, voffA);
            PG8_WAIT_L(8); PG8_BAR; PG8_WAIT_L(0); PG8_MMA(0, 0, At, B0); PG8_BAR; PG8_SCHED;
            PG8_LDB(B1, 1, 1); PG8_STAGE(PG8_SB(1, 0), b3, voffB);
            PG8_BAR; PG8_WAIT_L(0); PG8_MMA(0, 1, At, B1); PG8_BAR;
            PG8_LDA(At, 1, 1); PG8_STAGE(PG8_SA(1, 0), a3, voffA);
            PG8_BAR; PG8_WAIT_L(0); PG8_MMA(1, 0, At, B0); PG8_BAR; PG8_SCHED;
            PG8_STAGE(PG8_SB(1, 1), b3 + hstep, voffB);
            PG8_WAIT_V(6); PG8_BAR; PG8_MMA(1, 1, At, B1); PG8_BAR;
            }
        }
        if constexpr (ALIGN_EPI) { if (wr == 0) PG8_BAR; }
        if constexpr (!Epi::AFTER_DRAIN) { E(acc, cur, wr, wc, fr, fq); S.done(cur); }
        if (!has_next) break;
#pragma unroll
        for (int a = 0; a < 2; ++a)
#pragma unroll
            for (int b = 0; b < 2; ++b)
#pragma unroll
                for (int m = 0; m < 4; ++m)
#pragma unroll
                    for (int n = 0; n < 2; ++n) acc[a][b][m][n] = (f32x4){0.f, 0.f, 0.f, 0.f};
        cur = nxt; cA = nA; cB = nB; ++ui;
        if constexpr (ALIGN_EPI) { if (wr == 1) PG8_BAR; }
    }
    PG8_WAIT_V(0);
    if constexpr (!ALIGN_EPI) { if (wr == 0) PG8_BAR; }
    PG8_BAR;
    if constexpr (Epi::AFTER_DRAIN) { E.fused(acc, cur, wr, wc, fr, fq, lds, wid, lane); S.done(cur); }
#undef PG8_SA
#undef PG8_SB
#undef PG8_STAGE
#undef PG8_LDA
#undef PG8_LDB
#undef PG8_MMA
#undef PG8_WAIT_V
#undef PG8_WAIT_L
#undef PG8_BAR
#undef PG8_SCHED
}
}

#ifndef DBGV
#define DBGV 2
#endif
#ifndef DBG
#define DBG 0
#endif
#ifndef MK_PER_PHASE
#define MK_PER_PHASE 0
#endif
constexpr int NWAVES = 8, NTHR = NWAVES * 64;
constexpr int NBATCH = 2, SEQ = 8192, T = NBATCH * SEQ, D = 1024;
constexpr int SUPER = 256, NSC = SEQ / SUPER;
constexpr int INCOLS = 7184;
constexpr int NA = 3072, NB_ = 4096;
constexpr float EPS = 1e-6f;
constexpr int NPH = 16;
constexpr size_t MiB = 1u << 20;
constexpr size_t WS_CTL = 0, CTL_ZERO_BYTES = 1 * MiB;
constexpr size_t WS_KEYS = 1 * MiB;
constexpr size_t WS_WIN = 2 * MiB;
constexpr size_t WS_WOUT = 16 * MiB;
constexpr size_t WS_WQ = 20 * MiB;
constexpr size_t WS_DT = 24 * MiB;
constexpr size_t WS_CDEC = 25 * MiB;
constexpr size_t WS_STATES = 26 * MiB;
constexpr size_t WS_HN = 58 * MiB;
constexpr size_t WS_PROJ = 90 * MiB;
constexpr size_t WS_H = WS_PROJ, WS_U = WS_PROJ + 64 * MiB, WS_VS = WS_PROJ + 96 * MiB;
constexpr size_t WS_IDX = 218 * MiB;
constexpr size_t WS_GATE = 226 * MiB;
constexpr size_t WS_HID = 234 * MiB;
constexpr size_t WS_END = 256 * MiB;
constexpr int CW_BAR = 4096;
constexpr int CW_SS1 = 32768;
constexpr int CW_SS2 = 32768 + T;
static_assert((CW_SS2 + T) * 4 <= (int)CTL_ZERO_BYTES, "ctl");
constexpr int LDS_BYTES = 147456;
constexpr int RING_BYTES = 131072, MISC_OFF = RING_BYTES + 320;

#define GAS __attribute__((address_space(1)))
#define LAS __attribute__((address_space(3)))
typedef unsigned short bf16;
typedef unsigned v4u __attribute__((ext_vector_type(4)));
typedef unsigned v2u __attribute__((ext_vector_type(2)));
typedef float f32x4 __attribute__((ext_vector_type(4)));
typedef float f32x16 __attribute__((ext_vector_type(16)));
typedef short bf16x8 __attribute__((ext_vector_type(8)));
typedef GAS unsigned gu32;
#define RLX_AGENT __ATOMIC_RELAXED, __HIP_MEMORY_SCOPE_AGENT
#define LDS_WAIT() asm volatile("s_waitcnt lgkmcnt(0)" ::: "memory")
__device__ __forceinline__ unsigned f2bf(float f) { unsigned u = __builtin_bit_cast(unsigned, f); return (u + 0x7fffu + ((u >> 16) & 1u)) >> 16; }
__device__ __forceinline__ unsigned pk2(float lo, float hi) { return f2bf(lo) | (f2bf(hi) << 16); }
__device__ __forceinline__ float bflo(unsigned w) { return __builtin_bit_cast(float, w << 16); }
__device__ __forceinline__ float bfhi(unsigned w) { return __builtin_bit_cast(float, w & 0xffff0000u); }
__device__ __forceinline__ float bf1(bf16 h) { return __builtin_bit_cast(float, (unsigned)h << 16); }
__device__ __forceinline__ float silu_f(float x) { return x / (1.f + __expf(-x)); }
__device__ __forceinline__ f32x4 mma16(bf16x8 a, bf16x8 b, f32x4 c) { return __builtin_amdgcn_mfma_f32_16x16x32_bf16(a, b, c, 0, 0, 0); }
__device__ __forceinline__ bf16x8 ldfrag(const LAS unsigned char* base, int pitchB, int row0, int k0, int lane) {
    return *(const LAS bf16x8*)(base + (row0 + (lane & 15)) * pitchB + (k0 + 8 * (lane >> 4)) * 2);
}
__device__ __forceinline__ float wave_sum(float v) {
#pragma unroll
    for (int o = 1; o < 64; o <<= 1) v += __shfl_xor(v, o);
    return v;
}
#define XB_TMO      128
#define XB_XCNT(j)  (256  + 64 * (j))
#define XB_XSUB(j)  (1280 + 64 * (j))
#define XB_XGEN(j)  (2304 + 64 * (j))
#define XB_TOP      3328
#define XB_TOPGEN   3392
#define XCD_BAR_WORDS 3456
#define XB_SPIN_CAP (1u << 18)

__device__ __forceinline__ unsigned xb_ld(unsigned* p)              { return __hip_atomic_load(p, __ATOMIC_RELAXED, __HIP_MEMORY_SCOPE_AGENT); }
__device__ __forceinline__ unsigned xb_add(unsigned* p, unsigned v) { return __hip_atomic_fetch_add(p, v, __ATOMIC_RELAXED, __HIP_MEMORY_SCOPE_AGENT); }
__device__ __forceinline__ unsigned xb_xcc_id() { return (unsigned)__builtin_amdgcn_s_getreg((3 << 11) | 20) & 0xFu; }
#define XB_SPIN(cond, bar) do { unsigned _sp = 0; while (cond) { __builtin_amdgcn_s_sleep(1); \
    if ((++_sp & 255u) == 0u) { if (xb_ld(&(bar)[XB_TMO])) break; if (_sp > XB_SPIN_CAP) { atomicAdd(&(bar)[XB_TMO], 1u); break; } } } } while (0)

struct XcdBarrier {
    unsigned* bar; unsigned x;
    volatile LAS unsigned* st;
};

__device__ __forceinline__ XcdBarrier xcd_barrier_post(unsigned* bar, volatile LAS unsigned* st) {
    XcdBarrier b; b.bar = bar; b.x = xb_xcc_id(); b.st = st;
    if (threadIdx.x == 0) (void)xb_add(&bar[XB_XCNT(b.x)], 1u);
    return b;
}
__device__ __forceinline__ void xcd_barrier_complete(unsigned* bar, unsigned x, unsigned& nloc, unsigned& nx) {
    const unsigned G = gridDim.x * gridDim.y * gridDim.z;
    unsigned sum, cnt, mine, sp = 0u;
    for (;;) {
        sum = 0u; cnt = 0u; mine = 0u;
#pragma unroll
        for (unsigned j = 0; j < 16; ++j) { const unsigned c = xb_ld(&bar[XB_XCNT(j)]); sum += c; cnt += (c > 0u) ? 1u : 0u; mine = (j == x) ? c : mine; }
        if (sum == G) break;
        __builtin_amdgcn_s_sleep(1);
        if ((++sp & 255u) == 0u) { if (xb_ld(&bar[XB_TMO])) break; if (sp > XB_SPIN_CAP) { atomicAdd(&bar[XB_TMO], 1u); break; } }
    }
    nloc = mine > 0u ? mine : 1u; nx = cnt > 0u ? cnt : 1u;
}

__device__ __forceinline__ void xcd_barrier(const XcdBarrier& b) {
    asm volatile("s_waitcnt vmcnt(0)" ::: "memory");
    __syncthreads();
    if (threadIdx.x == 0) {
        unsigned* bar = b.bar;
        __builtin_amdgcn_s_waitcnt(0);
        unsigned nloc = b.st[0], nx = b.st[1];
        if (nloc == 0u) { xcd_barrier_complete(bar, b.x, nloc, nx); b.st[0] = nloc; b.st[1] = nx; }
        const unsigned old = xb_add(&bar[XB_XSUB(b.x)], 1u);
        const unsigned gen = old / nloc;
        if (old + 1u == (gen + 1u) * nloc) {
            __builtin_amdgcn_fence(__ATOMIC_RELEASE, "agent");
            asm volatile("s_waitcnt vmcnt(0)" ::: "memory");
            const unsigned og = xb_add(&bar[XB_TOP], 1u);
            const unsigned tg = og / nx;
            if (og + 1u == (tg + 1u) * nx) xb_add(&bar[XB_TOPGEN], 1u);
            else XB_SPIN(xb_ld(&bar[XB_TOPGEN]) == tg, bar);
            __builtin_amdgcn_fence(__ATOMIC_ACQUIRE, "agent");
            xb_add(&bar[XB_XGEN(b.x)], 1u);
            asm volatile("s_waitcnt vmcnt(0)" ::: "memory");
        } else {
            XB_SPIN(xb_ld(&bar[XB_XGEN(b.x)]) == gen, bar);
            __builtin_amdgcn_fence(__ATOMIC_ACQUIRE, "agent");
            asm volatile("s_waitcnt vmcnt(0)" ::: "memory");
        }
    }
    __syncthreads();
}

struct Args { const float* in[18]; float* out; unsigned char* ws; int ph_lo, ph_hi; };
struct Frame {
    LAS unsigned char* lds;
    volatile LAS unsigned* MISC;
    gu32* ctl;
    unsigned char* ws;
    int tid, lane, wave, vcu, G;
    const Args* A;
    float* out;
};
#define BSYNC() __syncthreads()

__device__ __forceinline__ void p0_transpose_item(const float* W, int K, int ldw, int c0, bf16* WT, int n0, int k0, LAS float* scr, int lane) {
#pragma unroll 8
    for (int i = 0; i < 32; ++i) { const int kk = 2 * i + (lane >> 5); scr[kk * 33 + (lane & 31)] = W[(size_t)(k0 + kk) * ldw + c0 + (lane & 31)]; }
    LDS_WAIT(); asm volatile("" ::: "memory");
    const int c = lane & 7;
#pragma unroll
    for (int j = 0; j < 4; ++j) { const int n = (lane >> 3) + 8 * j; const LAS float* s = scr + (8 * c) * 33 + n;
        v4u o; o.x = pk2(s[0 * 33], s[1 * 33]); o.y = pk2(s[2 * 33], s[3 * 33]); o.z = pk2(s[4 * 33], s[5 * 33]); o.w = pk2(s[6 * 33], s[7 * 33]);
        *(GAS v4u*)(WT + (size_t)(n0 + n) * K + k0 + 8 * c) = o; }
    LDS_WAIT(); asm volatile("" ::: "memory");
}
__device__ __forceinline__ void p0_prologue(Frame& F) {
    const int gw = F.vcu * NWAVES + F.wave, NGW = F.G * NWAVES;
    {
        LAS float* scr = (LAS float*)(F.lds + F.wave * 8704);
        bf16* WIN = (bf16*)(F.ws + WS_WIN); bf16* WOUT = (bf16*)(F.ws + WS_WOUT); bf16* WQ = (bf16*)(F.ws + WS_WQ);
        constexpr int I_IN = (D / 64) * (7168 / 32), I_OUT = (2048 / 64) * (1024 / 32), I_Q = (1024 / 64) * (2048 / 32);
        for (int it = gw; it < I_IN + I_OUT + I_Q; it += NGW) {
            int r = it;
            if (r < I_IN) { const int nblk = 7168 / 32, kb = r / nblk, nb = r % nblk, n0 = 32 * nb; p0_transpose_item(F.A->in[2], 1024, INCOLS, n0 < NA ? n0 : n0 + 16, WIN, n0, 64 * kb, scr, F.lane); continue; } r -= I_IN;
            if (r < I_OUT) { const int nblk = 1024 / 32, kb = r / nblk, nb = r % nblk; p0_transpose_item(F.A->in[11], 2048, 1024, 32 * nb, WOUT, 32 * nb, 64 * kb, scr, F.lane); continue; } r -= I_OUT;
            { const int nblk = 2048 / 32, kb = r / nblk, nb = r % nblk; p0_transpose_item(F.A->in[13], 1024, 2048, 32 * nb, WQ, 32 * nb, 64 * kb, scr, F.lane); }
        }
    }
    {
        bf16* KEYS = (bf16*)(F.ws + WS_KEYS);
        for (int i = (F.vcu * NTHR + F.tid) * 4; i < 8 * 2 * 128 * 128; i += F.G * NTHR * 4) {
            const f32x4 v = *(const GAS f32x4*)(F.A->in[14] + i); v2u o; o.x = pk2(v.x, v.y); o.y = pk2(v.z, v.w); *(GAS v2u*)(KEYS + i) = o; }
    }
    BSYNC();
    LAS float* WDT = (LAS float*)F.lds;
    for (int i = F.tid; i < 16 * 1024; i += NTHR) { const int d = i >> 4, h = i & 15; WDT[h * 1024 + d] = F.A->in[2][(size_t)d * INCOLS + NA + h]; }
    BSYNC();
    bf16* HN = (bf16*)(F.ws + WS_HN); float* DT = (float*)(F.ws + WS_DT);
    for (int m = gw; m < T; m += NGW) {
        const GAS f32x4* xr = (const GAS f32x4*)(F.A->in[0] + (size_t)m * D) + F.lane;
        f32x4 v[4]; float s = 0.f;
#pragma unroll
        for (int j = 0; j < 4; ++j) { v[j] = xr[64 * j]; s += (v[j].x * v[j].x + v[j].y * v[j].y) + (v[j].z * v[j].z + v[j].w * v[j].w); }
        const float rstd = 1.f / sqrtf(wave_sum(s) * (1.f / D) + EPS);
        GAS v2u* o8 = (GAS v2u*)(HN + (size_t)m * D) + F.lane;
#pragma unroll
        for (int j = 0; j < 4; ++j) { const f32x4 w = *((const GAS f32x4*)F.A->in[1] + F.lane + 64 * j); v[j] = v[j] * rstd * w; v2u o; o.x = pk2(v[j].x, v[j].y); o.y = pk2(v[j].z, v[j].w); o8[64 * j] = o; }
        float p[16];
#pragma unroll 2
        for (int h = 0; h < 16; ++h) { float a = 0.f;
#pragma unroll
            for (int j = 0; j < 4; ++j) { const f32x4 w = *(const LAS f32x4*)(WDT + h * 1024 + 4 * F.lane + 256 * j); a += (v[j].x * w.x + v[j].y * w.y) + (v[j].z * w.z + v[j].w * w.w); }
            p[h] = a; }
#pragma unroll
        for (int h = 0; h < 16; ++h) p[h] = wave_sum(p[h]);
        if (F.lane < 16) { float r = p[0];
#pragma unroll
            for (int h = 1; h < 16; ++h) r = (F.lane == h) ? p[h] : r;
            const float xx = r + F.A->in[5][F.lane]; DT[(size_t)m * 16 + F.lane] = xx > 20.f ? xx : log1pf(__expf(xx)); }
    }
    BSYNC();
}

struct EpiG1b {
    static constexpr bool PERM = true, AFTER_DRAIN = false;
    bf16* O; const float* lbl;
    __device__ __forceinline__ void operator()(const pg8::f32x4 (&acc)[2][2][4][2], const pg8::Unit& u, int wr, int wc, int fr, int fq) const {
        const int row0 = u.pm * 256 + wr * 64 + fr, col0 = u.pn * 256 + wc * 32 + 8 * fq, grp = u.pn >> 2;
        float lb[2][8];
        if (grp == 1) {
#pragma unroll
            for (int bj = 0; bj < 2; ++bj)
#pragma unroll
                for (int e = 0; e < 8; ++e) { const int k = col0 - 1024 + bj * 128 + e; lb[bj][e] = 1.f / (1.f + __expf(lbl[1024 + k] - lbl[k])); }
        }
#pragma unroll
        for (int ai = 0; ai < 2; ++ai)
#pragma unroll
            for (int m = 0; m < 4; ++m) { bf16* rowp = O + (size_t)(row0 + ai * 128 + m * 16) * NB_ + col0;
#pragma unroll
                for (int bj = 0; bj < 2; ++bj) { float v[8];
#pragma unroll
                    for (int e = 0; e < 8; ++e) v[e] = acc[ai][bj][m][e >> 2][e & 3];
                    if (grp == 0 || grp == 3) {
#pragma unroll
                        for (int e = 0; e < 8; ++e) v[e] = silu_f(v[e]);
                    } else if (grp == 1) {
#pragma unroll
                        for (int e = 0; e < 8; ++e) { const float sg = 1.f / (1.f + __expf(-v[e])); v[e] = __logf(lb[bj][e] + (1.f - lb[bj][e]) * sg); }
                    }
                    v4u w; w.x = pk2(v[0], v[1]); w.y = pk2(v[2], v[3]); w.z = pk2(v[4], v[5]); w.w = pk2(v[6], v[7]);
                    *(v4u*)(rowp + bj * 128) = w; } }
    }
};
struct EpiRes {
    static constexpr bool PERM = false, AFTER_DRAIN = false;
    const float* X; float* H;
    __device__ __forceinline__ void operator()(const pg8::f32x4 (&acc)[2][2][4][2], const pg8::Unit& u, int wr, int wc, int fr, int fq) const {
        const int row0 = u.pm * 256 + wr * 64 + fr, col0 = u.pn * 256 + wc * 32 + 4 * fq;
#pragma unroll
        for (int ai = 0; ai < 2; ++ai)
#pragma unroll
            for (int m = 0; m < 4; ++m) { const size_t off = (size_t)(row0 + ai * 128 + m * 16) * D + col0;
#pragma unroll
                for (int bj = 0; bj < 2; ++bj)
#pragma unroll
                    for (int n = 0; n < 2; ++n) { const pg8::f32x4 xv = *(const pg8::f32x4*)(X + off + bj * 128 + n * 16); *(pg8::f32x4*)(H + off + bj * 128 + n * 16) = xv + acc[ai][bj][m][n]; } }
    }
};

constexpr int S_ACUM = 0, S_DTL = 4096;
constexpr int SA_XWT = 8192, SA_BMT = 45056;
constexpr int SB_CM = 8192, SB_BM = 25600, SB_XDTT = 43008, SB_CB = 79872, SB_YST = 97280;
constexpr int P72 = 144, P136 = 272;

template <bool TR>
__device__ __forceinline__ void conv8x8(const Frame& F, const bf16* P, size_t tok0, int pos0, int col0, int cch0, const float (&sc)[8], LAS unsigned char* dst, int pitchB) {
    asm volatile("" : "+v"(cch0), "+v"(col0));
    f32x4 w[4][2], bb[2];
#pragma unroll
    for (int k = 0; k < 4; ++k) { w[k][0] = *(const GAS f32x4*)(F.A->in[3] + k * 2048 + cch0); w[k][1] = *(const GAS f32x4*)(F.A->in[3] + k * 2048 + cch0 + 4); }
    bb[0] = *(const GAS f32x4*)(F.A->in[4] + cch0); bb[1] = *(const GAS f32x4*)(F.A->in[4] + cch0 + 4);
    const bf16* base = P + tok0 * NA + col0;
#pragma unroll
    for (int hf = 0; hf < 2; ++hf) {
        v4u raw[7];
#pragma unroll
        for (int rr = 0; rr < 7; ++rr) { const int dr = 4 * hf + rr - 3; const int drc = (pos0 + dr >= 0) ? dr : 0; const v4u ld = *(const GAS v4u*)(base + (long)drc * NA); raw[rr] = (pos0 + dr >= 0) ? ld : (v4u){0u, 0u, 0u, 0u}; }
#pragma unroll
        for (int c = 0; c < 8; c += 2) {
            float o[2][4];
#pragma unroll
            for (int dc = 0; dc < 2; ++dc)
#pragma unroll
                for (int t = 0; t < 4; ++t) { float a = bb[(c + dc) >> 2][(c + dc) & 3];
#pragma unroll
                    for (int k = 0; k < 4; ++k) { const unsigned ww = raw[t + k][c >> 1]; a += w[k][(c + dc) >> 2][(c + dc) & 3] * (dc ? bfhi(ww) : bflo(ww)); }
                    o[dc][t] = silu_f(a) * sc[4 * hf + t]; }
            if (TR) {
                v2u p0, p1; p0.x = pk2(o[0][0], o[0][1]); p0.y = pk2(o[0][2], o[0][3]); p1.x = pk2(o[1][0], o[1][1]); p1.y = pk2(o[1][2], o[1][3]);
                *(LAS v2u*)(dst + c * pitchB + 8 * hf) = p0; *(LAS v2u*)(dst + (c + 1) * pitchB + 8 * hf) = p1;
            } else {
#pragma unroll
                for (int t = 0; t < 4; ++t) *(LAS unsigned*)(dst + (4 * hf + t) * pitchB + 2 * c) = pk2(o[0][t], o[1][t]);
            }
        }
    }
}
__device__ __forceinline__ void ssd_acum(Frame& F, size_t tok0, int g) {
    LAS float* ACUM = (LAS float*)(F.lds + S_ACUM); LAS float* DTL = (LAS float*)(F.lds + S_DTL);
    const float* DT = (const float*)(F.ws + WS_DT);
    if (F.wave < 4) { const int r = F.wave, h = 4 * g + r; const float A = -__expf(F.A->in[6][h]);
        float dtv[4], a[4];
#pragma unroll
        for (int i = 0; i < 4; ++i) { dtv[i] = DT[(tok0 + 4 * F.lane + i) * 16 + h]; a[i] = dtv[i] * A; }
        a[1] += a[0]; a[2] += a[1]; a[3] += a[2];
        const float tot = a[3]; float sc = tot;
#pragma unroll
        for (int o = 1; o < 64; o <<= 1) { const float t = __shfl_up(sc, o); if (F.lane >= o) sc += t; }
        const float excl = sc - tot;
#pragma unroll
        for (int i = 0; i < 4; ++i) { ACUM[(4 * F.lane + i) * 4 + r] = a[i] + excl; DTL[(4 * F.lane + i) * 4 + r] = dtv[i]; }
    }
    BSYNC();
}
__device__ __forceinline__ void ssd_pass_a(Frame& F) {
    const bf16* P = (const bf16*)(F.ws + WS_PROJ); float* ST = (float*)(F.ws + WS_STATES); float* CDEC = (float*)(F.ws + WS_CDEC);
    LAS float* ACUM = (LAS float*)(F.lds + S_ACUM); LAS float* DTL = (LAS float*)(F.lds + S_DTL);
    for (int item = F.vcu; item < NBATCH * NSC * 4; item += F.G) {
        const int g = item & 3, cs = (item >> 2) % NSC, b = item / (4 * NSC);
        const size_t tok0 = (size_t)b * SEQ + (size_t)cs * SUPER;
        ssd_acum(F, tok0, g);
        const int cg = F.tid % 48, run = F.tid / 48;
        const int cch0 = cg < 32 ? g * 256 + 8 * cg : 1024 + g * 128 + 8 * (cg - 32), col0 = 1024 + cch0;
        f32x4 acc[4][4];
#pragma unroll
        for (int i = 0; i < 4; ++i)
#pragma unroll
            for (int j = 0; j < 4; ++j) acc[i][j] = (f32x4){0.f, 0.f, 0.f, 0.f};
        const int r = F.wave >> 1, nh = F.wave & 1;
#pragma unroll 1
        for (int s = 0; s < 4; ++s) {
            if (F.tid < 384) {
                float sc[8]; const int rr = (cg >> 3) & 3; const float aend = ACUM[255 * 4 + rr];
#pragma unroll
                for (int t = 0; t < 8; ++t) { const int l = 64 * s + 8 * run + t; sc[t] = cg < 32 ? DTL[l * 4 + rr] * __expf(aend - ACUM[l * 4 + rr]) : 1.f; }
                LAS unsigned char* dst = cg < 32 ? F.lds + SA_XWT + (8 * cg) * P72 : F.lds + SA_BMT + (8 * (cg - 32)) * P72;
                conv8x8<true>(F, P, tok0 + 64 * s + 8 * run, cs * SUPER + 64 * s + 8 * run, col0, cch0, sc, dst + 16 * run, P72);
            }
            BSYNC();
#pragma unroll
            for (int ks = 0; ks < 2; ++ks) { bf16x8 a[4], bb[4];
#pragma unroll
                for (int i = 0; i < 4; ++i) { a[i] = ldfrag(F.lds + SA_XWT, P72, r * 64 + 16 * i, 32 * ks, F.lane); bb[i] = ldfrag(F.lds + SA_BMT, P72, nh * 64 + 16 * i, 32 * ks, F.lane); }
#pragma unroll
                for (int i = 0; i < 4; ++i)
#pragma unroll
                    for (int j = 0; j < 4; ++j) acc[i][j] = mma16(a[i], bb[j], acc[i][j]); }
            BSYNC();
        }
        const int h = 4 * g + r; int ln = F.lane; asm volatile("" : "+v"(ln));
        float* dst = ST + ((size_t)(b * NSC + cs) * 16 + h) * 8192 + (4 * (ln >> 4)) * 128 + nh * 64 + (ln & 15);
#pragma unroll
        for (int i = 0; i < 4; ++i)
#pragma unroll
            for (int j = 0; j < 4; ++j)
#pragma unroll
                for (int e = 0; e < 4; ++e) dst[(16 * i + e) * 128 + 16 * j] = acc[i][j][e];
        if (F.tid < 4) CDEC[(b * NSC + cs) * 16 + 4 * g + F.tid] = __expf(ACUM[255 * 4 + F.tid]);
        BSYNC();
    }
}
__device__ __forceinline__ void ssd_scan(Frame& F) {
    float* ST = (float*)(F.ws + WS_STATES); const float* CDEC = (const float*)(F.ws + WS_CDEC);
    for (int e = F.vcu * NTHR + F.tid; e < NBATCH * 16 * 8192; e += F.G * NTHR) {
        const int el = e & 8191, h = (e >> 13) & 15, b = e >> 17; float run = 0.f;
        for (int c = 0; c < NSC; ++c) { const size_t o = ((size_t)(b * NSC + c) * 16 + h) * 8192 + el; const float loc = ST[o]; ST[o] = run; run = run * CDEC[(b * NSC + c) * 16 + h] + loc; }
    }
}
__device__ __forceinline__ void ssd_pass_b(Frame& F) {
    const bf16* P = (const bf16*)(F.ws + WS_PROJ); const float* ST = (const float*)(F.ws + WS_STATES);
    bf16* MIX = (bf16*)F.out; float* SS1 = (float*)(F.ctl + CW_SS1);
    LAS float* ACUM = (LAS float*)(F.lds + S_ACUM); LAS float* DTL = (LAS float*)(F.lds + S_DTL);
    LAS float* CB = (LAS float*)(F.lds + SB_CB);
    for (int item = F.vcu; item < NBATCH * NSC * 4; item += F.G) {
        const int g = item & 3, cs = (item >> 2) % NSC, b = item / (4 * NSC);
        const size_t tok0 = (size_t)b * SEQ + (size_t)cs * SUPER;
        ssd_acum(F, tok0, g);
        const int cg = F.tid % 48, run = F.tid / 48;
        const int cch0 = cg < 32 ? g * 256 + 8 * cg : 1024 + g * 128 + 8 * (cg - 32), col0 = 1024 + cch0;
        const int r = F.wave >> 1, lh = F.wave & 1, h = 4 * g + r;
        const float Dh = F.A->in[7][h];
        const float* prev = ST + ((size_t)(b * NSC + cs) * 16 + h) * 8192;
#pragma unroll 1
        for (int i = 0; i < 4; ++i) {
            if (F.tid < 128) { const int rn = F.tid >> 4, cgc = F.tid & 15, cchc = 1536 + g * 128 + 8 * cgc; float sc[8];
#pragma unroll
                for (int t = 0; t < 8; ++t) sc[t] = 1.f;
                conv8x8<false>(F, P, tok0 + 64 * i + 8 * rn, cs * SUPER + 64 * i + 8 * rn, 1024 + cchc, cchc, sc, F.lds + SB_CM + (8 * rn) * P136 + 16 * cgc, P136); }
            BSYNC();
            f32x4 y[2][4];
#pragma unroll
            for (int a = 0; a < 2; ++a)
#pragma unroll
                for (int c = 0; c < 4; ++c) y[a][c] = (f32x4){0.f, 0.f, 0.f, 0.f};
#pragma unroll 1
            for (int ks = 0; ks < 4; ++ks) { bf16x8 a0 = ldfrag(F.lds + SB_CM, P136, 32 * lh, 32 * ks, F.lane), a1 = ldfrag(F.lds + SB_CM, P136, 32 * lh + 16, 32 * ks, F.lane);
#pragma unroll
                for (int pt = 0; pt < 4; ++pt) { const float* pp = prev + (16 * pt + (F.lane & 15)) * 128 + 32 * ks + 8 * (F.lane >> 4);
                    const f32x4 u0 = *(const GAS f32x4*)pp, u1 = *(const GAS f32x4*)(pp + 4);
                    v4u w; w.x = pk2(u0.x, u0.y); w.y = pk2(u0.z, u0.w); w.z = pk2(u1.x, u1.y); w.w = pk2(u1.z, u1.w);
                    const bf16x8 bb = __builtin_bit_cast(bf16x8, w);
                    y[0][pt] = mma16(a0, bb, y[0][pt]); y[1][pt] = mma16(a1, bb, y[1][pt]); } }
#pragma unroll
            for (int a = 0; a < 2; ++a)
#pragma unroll
                for (int e = 0; e < 4; ++e) { const float sc = __expf(ACUM[(64 * i + 32 * lh + 16 * a + 4 * (F.lane >> 4) + e) * 4 + r]);
#pragma unroll
                    for (int pt = 0; pt < 4; ++pt) y[a][pt][e] *= sc; }
#pragma unroll 1
            for (int j = 0; j <= i; ++j) {
                BSYNC();
                if (F.tid < 384) {
                    float sc[8]; const int rr = (cg >> 3) & 3;
#pragma unroll
                    for (int t = 0; t < 8; ++t) sc[t] = cg < 32 ? DTL[(64 * j + 8 * run + t) * 4 + rr] : 1.f;
                    if (cg < 32) conv8x8<true>(F, P, tok0 + 64 * j + 8 * run, cs * SUPER + 64 * j + 8 * run, col0, cch0, sc, F.lds + SB_XDTT + (8 * cg) * P72 + 16 * run, P72);
                    else conv8x8<false>(F, P, tok0 + 64 * j + 8 * run, cs * SUPER + 64 * j + 8 * run, col0, cch0, sc, F.lds + SB_BM + (8 * run) * P136 + 16 * (cg - 32), P136);
                }
                BSYNC();
#pragma unroll
                for (int e2 = 0; e2 < 2; ++e2) { const int tt = 2 * F.wave + e2, rt = tt >> 2, ct = tt & 3; f32x4 c = (f32x4){0.f, 0.f, 0.f, 0.f};
#pragma unroll
                    for (int ks = 0; ks < 4; ++ks) c = mma16(ldfrag(F.lds + SB_CM, P136, 16 * rt, 32 * ks, F.lane), ldfrag(F.lds + SB_BM, P136, 16 * ct, 32 * ks, F.lane), c);
#pragma unroll
                    for (int e = 0; e < 4; ++e) CB[(16 * rt + 4 * (F.lane >> 4) + e) * 68 + 16 * ct + (F.lane & 15)] = c[e]; }
                BSYNC();
#pragma unroll
                for (int a = 0; a < 2; ++a) { const int l = 32 * lh + 16 * a + (F.lane & 15); const float al = ACUM[(64 * i + l) * 4 + r]; const bool diag = (i == j); const float ddt = Dh / DTL[(64 * i + l) * 4 + r];
#pragma unroll
                    for (int ks = 0; ks < 2; ++ks) { const int s0 = 32 * ks + 8 * (F.lane >> 4);
                        const f32x4 c0 = *(const LAS f32x4*)(CB + l * 68 + s0), c1 = *(const LAS f32x4*)(CB + l * 68 + s0 + 4);
                        float m[8];
#pragma unroll
                        for (int e = 0; e < 8; ++e) { const int s = s0 + e; const float as = ACUM[(64 * j + s) * 4 + r]; const float cbv = e < 4 ? c0[e] : c1[e - 4];
                            float v = cbv * __expf(fminf(al - as, 0.f));
                            v = (diag && s > l) ? 0.f : v; v += (diag && s == l) ? ddt : 0.f;
                            m[e] = v; }
                        v4u w; w.x = pk2(m[0], m[1]); w.y = pk2(m[2], m[3]); w.z = pk2(m[4], m[5]); w.w = pk2(m[6], m[7]);
                        const bf16x8 ma = __builtin_bit_cast(bf16x8, w);
#pragma unroll
                        for (int pt = 0; pt < 4; ++pt) y[a][pt] = mma16(ma, ldfrag(F.lds + SB_XDTT, P72, r * 64 + 16 * pt, 32 * ks, F.lane), y[a][pt]);
                        __builtin_amdgcn_sched_barrier(0); } }
            }
            int ln2 = F.lane; asm volatile("" : "+v"(ln2)); LAS unsigned char* ystb = F.lds + SB_YST + (32 * lh + 4 * (ln2 >> 4)) * 528 + (r * 64 + (ln2 & 15)) * 2;
#pragma unroll
            for (int a = 0; a < 2; ++a)
#pragma unroll
                for (int pt = 0; pt < 4; ++pt)
#pragma unroll
                    for (int e = 0; e < 4; ++e) *(LAS bf16*)(ystb + (16 * a + e) * 528 + (16 * pt) * 2) = (bf16)f2bf(y[a][pt][e]);
            BSYNC();
#pragma unroll
            for (int q = 0; q < 4; ++q) { const int idx = F.tid + NTHR * q, l = idx >> 5, c8 = idx & 31; const size_t tok = tok0 + 64 * i + l;
                const v4u yv = *(const LAS v4u*)(F.lds + SB_YST + l * 528 + 16 * c8); const v4u zv = *(const GAS v4u*)(P + tok * NA + g * 256 + 8 * c8);
                float o[8]; float ss = 0.f;
#pragma unroll
                for (int e = 0; e < 4; ++e) { o[2 * e] = bflo(yv[e]) * silu_f(bflo(zv[e])); o[2 * e + 1] = bfhi(yv[e]) * silu_f(bfhi(zv[e])); ss += o[2 * e] * o[2 * e] + o[2 * e + 1] * o[2 * e + 1]; }
                v4u w; w.x = pk2(o[0], o[1]); w.y = pk2(o[2], o[3]); w.z = pk2(o[4], o[5]); w.w = pk2(o[6], o[7]);
                *(GAS v4u*)(MIX + tok * 2048 + g * 256 + 8 * c8) = w;
#pragma unroll
                for (int o2 = 1; o2 < 32; o2 <<= 1) ss += __shfl_xor(ss, o2);
                if (c8 == 0) atomicAdd(SS1 + tok, ss); }
            BSYNC();
        }
    }
}
__device__ __forceinline__ void ssd_norm(Frame& F) {
    bf16* MIX = (bf16*)F.out; const float* SS1 = (const float*)(F.ctl + CW_SS1);
    const int gw = F.vcu * NWAVES + F.wave, NGW = F.G * NWAVES;
    for (int m = gw; m < T; m += NGW) { const float rstd = 1.f / sqrtf(__hip_atomic_load(SS1 + m, RLX_AGENT) * (1.f / 1024.f) + EPS);
#pragma unroll
        for (int j = 0; j < 2; ++j) { GAS v4u* p = (GAS v4u*)(MIX + (size_t)m * 2048 + 512 * j) + F.lane; const v4u v = *p; const float* w = F.A->in[8] + 512 * j + 8 * F.lane; v4u o;
#pragma unroll
            for (int e = 0; e < 4; ++e) o[e] = DBG == 3 ? 0u : pk2(bflo(v[e]) * rstd * w[2 * e], bfhi(v[e]) * rstd * w[2 * e + 1]);
            *p = o; } }
}

constexpr int H_QG = 0, H_KG = 17408, H_KENDT = 34816, H_VT = 53248, H_ATT = 71680, H_ST = 80896, H_GQ = 115712, H_DEC = 117760, H_SSQ = 118272;
template <bool PASS_B>
__device__ __forceinline__ void hg_pass(Frame& F) {
    const bf16* P = (const bf16*)(F.ws + WS_PROJ); float* STG = (float*)(F.ws + WS_STATES); float* CDEC = (float*)(F.ws + WS_CDEC) + 4096;
    bf16* MIX = (bf16*)F.out;
    LAS float* GQ = (LAS float*)(F.lds + H_GQ); LAS float* DEC = (LAS float*)(F.lds + H_DEC); LAS float* SSQ = (LAS float*)(F.lds + H_SSQ);
    const int k = F.tid & 127, qtr = F.tid >> 7, w = F.wave;
    for (int item = F.vcu; item < NBATCH * NSC * 8; item += F.G) {
        const int h = item & 7, cs = (item >> 3) % NSC, b = item / (8 * NSC);
        const size_t tok0 = (size_t)b * SEQ + (size_t)cs * SUPER;
        float* stg = STG + ((size_t)(b * NSC + cs) * 8 + h) * 16384;
        int ln = F.lane; asm volatile("" : "+v"(ln)); const int lbase = (16 * w + 4 * (ln >> 4)) * 128 + (ln & 15);
        f32x4 S[8];
#pragma unroll
        for (int kt = 0; kt < 8; ++kt) {
            if (PASS_B) {
#pragma unroll
                for (int e = 0; e < 4; ++e) S[kt][e] = stg[lbase + e * 128 + 16 * kt];
            } else S[kt] = (f32x4){0.f, 0.f, 0.f, 0.f};
        }
        if (PASS_B) {
#pragma unroll
            for (int kt = 0; kt < 8; ++kt)
#pragma unroll
                for (int e = 0; e < 4; ++e) *(LAS bf16*)(F.lds + H_ST + (16 * w + 4 * (ln >> 4)) * 272 + (ln & 15) * 2 + e * 272 + 32 * kt) = (bf16)f2bf(S[kt][e]);
        }
        float gtot = 0.f;
#pragma unroll 1
        for (int j = 0; j < 4; ++j) {
            const size_t trow = tok0 + 64 * j + 16 * qtr;
            float lf[16]; v4u wv[2];
#pragma unroll
            for (int t = 0; t < 16; t += 2) { lf[t] = bf1(P[(trow + t) * NB_ + 1024 + h * 128 + k]); lf[t + 1] = bf1(P[(trow + t + 1) * NB_ + 1024 + h * 128 + k]);
                wv[t >> 3][(t >> 1) & 3] = (unsigned)P[(trow + t) * NB_ + 2048 + h * 128 + k] | ((unsigned)P[(trow + t + 1) * NB_ + 2048 + h * 128 + k] << 16); }
            float cum[16]; cum[0] = lf[0];
#pragma unroll
            for (int t = 1; t < 16; ++t) cum[t] = cum[t - 1] + lf[t];
            GQ[qtr * 128 + k] = cum[15];
            BSYNC();
            float pre = 0.f, gend = 0.f;
#pragma unroll
            for (int q2 = 0; q2 < 4; ++q2) { const float gq = GQ[q2 * 128 + k]; if (q2 < qtr) pre += gq; gend += gq; }
            gtot += gend;
            if (qtr == 0) DEC[k] = __expf(gend);
            {   v4u wk[2];
#pragma unroll
                for (int t = 0; t < 16; t += 2) { float ke[2];
#pragma unroll
                    for (int u = 0; u < 2; ++u) { const float kk = 1.f - __expf(lf[t + u]); ke[u] = kk * __expf(gend - (pre + cum[t + u])); }
                    wk[t >> 3][(t >> 1) & 3] = pk2(ke[0], ke[1]); }
                *(LAS v4u*)(F.lds + H_KENDT + k * P72 + 32 * qtr) = wk[0]; *(LAS v4u*)(F.lds + H_KENDT + k * P72 + 32 * qtr + 16) = wk[1];
                *(LAS v4u*)(F.lds + H_VT + k * P72 + 32 * qtr) = wv[0]; *(LAS v4u*)(F.lds + H_VT + k * P72 + 32 * qtr + 16) = wv[1];
            }
            if (PASS_B) {
#pragma unroll
                for (int t = 0; t < 16; ++t) { const float gc = pre + cum[t]; const float q = bf1(P[(trow + t) * NB_ + h * 128 + k]); const float kk = 1.f - __expf(lf[t]);
                    *(LAS bf16*)(F.lds + H_QG + (16 * qtr + t) * P136 + 2 * k) = (bf16)f2bf(q * __expf(gc));
                    *(LAS bf16*)(F.lds + H_KG + (16 * qtr + t) * P136 + 2 * k) = (bf16)f2bf(kk * __expf(-gc)); }
            }
            BSYNC();
            f32x4 o[4];
            if (PASS_B) {
#pragma unroll
                for (int e2 = 0; e2 < 2; ++e2) { const int tt = 2 * w + e2, rt = tt >> 2, ct = tt & 3; f32x4 c = (f32x4){0.f, 0.f, 0.f, 0.f};
#pragma unroll
                    for (int ks = 0; ks < 4; ++ks) c = mma16(ldfrag(F.lds + H_QG, P136, 16 * rt, 32 * ks, F.lane), ldfrag(F.lds + H_KG, P136, 16 * ct, 32 * ks, F.lane), c);
#pragma unroll
                    for (int e = 0; e < 4; ++e) { const int l = 16 * rt + 4 * (F.lane >> 4) + e, s = 16 * ct + (F.lane & 15);
                        *(LAS bf16*)(F.lds + H_ATT + l * P72 + 2 * s) = (bf16)f2bf(s <= l ? c[e] : 0.f); } }
#pragma unroll
                for (int lt = 0; lt < 4; ++lt) o[lt] = (f32x4){0.f, 0.f, 0.f, 0.f};
#pragma unroll
                for (int ks = 0; ks < 4; ++ks) { const bf16x8 bb = ldfrag(F.lds + H_ST, P136, 16 * w, 32 * ks, F.lane);
#pragma unroll
                    for (int lt = 0; lt < 4; ++lt) o[lt] = mma16(ldfrag(F.lds + H_QG, P136, 16 * lt, 32 * ks, F.lane), bb, o[lt]); }
                BSYNC();
#pragma unroll
                for (int ks = 0; ks < 2; ++ks) { const bf16x8 bb = ldfrag(F.lds + H_VT, P72, 16 * w, 32 * ks, F.lane);
#pragma unroll
                    for (int lt = 0; lt < 4; ++lt) o[lt] = mma16(ldfrag(F.lds + H_ATT, P72, 16 * lt, 32 * ks, F.lane), bb, o[lt]); }
            }
#pragma unroll
            for (int kt = 0; kt < 8; ++kt) { const float dk = DEC[16 * kt + (F.lane & 15)]; S[kt] = S[kt] * dk; }
#pragma unroll
            for (int ks = 0; ks < 2; ++ks) { const bf16x8 a = ldfrag(F.lds + H_VT, P72, 16 * w, 32 * ks, F.lane);
#pragma unroll
                for (int kt = 0; kt < 8; ++kt) S[kt] = mma16(a, ldfrag(F.lds + H_KENDT, P72, 16 * kt, 32 * ks, F.lane), S[kt]); }
            if (PASS_B) {
                int l3 = F.lane; asm volatile("" : "+v"(l3)); LAS unsigned char* stb = F.lds + H_ST + (16 * w + 4 * (l3 >> 4)) * P136 + (l3 & 15) * 2;
#pragma unroll
                for (int kt = 0; kt < 8; ++kt)
#pragma unroll
                    for (int e = 0; e < 4; ++e) *(LAS bf16*)(stb + e * P136 + 32 * kt) = (bf16)f2bf(S[kt][e]);
#pragma unroll
                for (int lt = 0; lt < 4; ++lt)
#pragma unroll
                    for (int e = 0; e < 4; ++e) { float ss = o[lt][e] * o[lt][e];
#pragma unroll
                        for (int o2 = 1; o2 < 16; o2 <<= 1) ss += __shfl_xor(ss, o2);
                        if ((F.lane & 15) == 0) SSQ[(16 * lt + 4 * (F.lane >> 4) + e) * 8 + w] = ss; }
                BSYNC();
                const int vcol = 16 * w + (F.lane & 15); const float nw = F.A->in[10][h * 128 + vcol];
#pragma unroll
                for (int lt = 0; lt < 4; ++lt)
#pragma unroll
                    for (int e = 0; e < 4; ++e) { const int l = 16 * lt + 4 * (F.lane >> 4) + e; const f32x4 s0 = *(const LAS f32x4*)(SSQ + l * 8), s1 = *(const LAS f32x4*)(SSQ + l * 8 + 4);
                        const float rstd = 1.f / sqrtf(((s0.x + s0.y) + (s0.z + s0.w) + (s1.x + s1.y) + (s1.z + s1.w)) * (1.f / 128.f) + EPS);
                        const size_t tok = tok0 + 64 * j + l; const float gt = bf1(P[tok * NB_ + 3072 + h * 128 + vcol]);
                        MIX[tok * 2048 + 1024 + h * 128 + vcol] = (bf16)f2bf(DBG == 2 ? 0.f : o[lt][e] * rstd * nw * gt); }
            }
            BSYNC();
        }
        if (!PASS_B) {
            int l4 = F.lane; asm volatile("" : "+v"(l4)); const int lb2 = (16 * w + 4 * (l4 >> 4)) * 128 + (l4 & 15);
#pragma unroll
            for (int kt = 0; kt < 8; ++kt)
#pragma unroll
                for (int e = 0; e < 4; ++e) stg[lb2 + e * 128 + 16 * kt] = S[kt][e];
            if (qtr == 0) CDEC[((b * NSC + cs) * 8 + h) * 128 + k] = __expf(gtot);
        }
        BSYNC();
    }
}
__device__ __forceinline__ void hg_scan(Frame& F) {
    float* ST = (float*)(F.ws + WS_STATES); const float* CDEC = (const float*)(F.ws + WS_CDEC) + 4096;
    for (int e = F.vcu * NTHR + F.tid; e < NBATCH * 8 * 16384; e += F.G * NTHR) {
        const int el = e & 16383, kk = el & 127, h = (e >> 14) & 7, b = e >> 17; float run = 0.f;
        for (int c = 0; c < NSC; ++c) { const size_t o = ((size_t)(b * NSC + c) * 8 + h) * 16384 + el; const float loc = ST[o]; ST[o] = run; run = run * CDEC[((b * NSC + c) * 8 + h) * 128 + kk] + loc; }
    }
}

__device__ __forceinline__ void peer_prep(Frame& F) {
    const int gw = F.vcu * NWAVES + F.wave, NGW = F.G * NWAVES;
    const float* H = (const float*)(F.ws + WS_H); bf16* XN = (bf16*)(F.ws + WS_HN); bf16* U = (bf16*)(F.ws + WS_U); bf16* VS = (bf16*)(F.ws + WS_VS);
    for (int m = gw; m < T; m += NGW) {
        const GAS f32x4* xr = (const GAS f32x4*)(H + (size_t)m * D) + F.lane; f32x4 v[4]; float s = 0.f;
#pragma unroll
        for (int j = 0; j < 4; ++j) { v[j] = xr[64 * j]; s += (v[j].x * v[j].x + v[j].y * v[j].y) + (v[j].z * v[j].z + v[j].w * v[j].w); }
        const float rstd = 1.f / sqrtf(wave_sum(s) * (1.f / D) + EPS);
        GAS v2u* o8 = (GAS v2u*)(XN + (size_t)m * D) + F.lane;
#pragma unroll
        for (int j = 0; j < 4; ++j) { const f32x4 w = *((const GAS f32x4*)F.A->in[12] + F.lane + 64 * j); v[j] = v[j] * rstd * w; v2u o; o.x = pk2(v[j].x, v[j].y); o.y = pk2(v[j].z, v[j].w); o8[64 * j] = o; }
    }
    for (int e = gw; e < 16384; e += NGW) {
        const GAS f32x4* ur = (const GAS f32x4*)(F.A->in[15] + (size_t)e * D) + F.lane; const GAS f32x4* vr = (const GAS f32x4*)(F.A->in[16] + (size_t)e * D) + F.lane;
#pragma unroll
        for (int j = 0; j < 4; ++j) { const f32x4 a = ur[64 * j], c = vr[64 * j]; v2u o; o.x = pk2(a.x, a.y); o.y = pk2(a.z, a.w); *((GAS v2u*)(U + (size_t)e * D) + F.lane + 64 * j) = o;
            const int d = 4 * F.lane + 256 * j; v2u p; p.x = pk2(c.x, c.y); p.y = pk2(c.z, c.w); *(GAS v2u*)(VS + ((size_t)(d >> 7) * 16384 + e) * 128 + (d & 127)) = p; }
    }
}
__device__ __forceinline__ void cas(float& hi, float& lo) { float a, b; asm("v_max_f32 %0, %1, %2" : "=v"(a) : "v"(hi), "v"(lo)); asm("v_min_f32 %0, %1, %2" : "=v"(b) : "v"(hi), "v"(lo)); hi = a; lo = b; }
__device__ __forceinline__ float vmaxf(float x, float y) { float a; asm("v_max_f32 %0, %1, %2" : "=v"(a) : "v"(x), "v"(y)); return a; }
__device__ __forceinline__ void bitonic_merge16(float (&v)[16]) {
#pragma unroll
    for (int j = 8; j >= 1; j >>= 1)
#pragma unroll
        for (int i = 0; i < 16; ++i) { const int l = i ^ j; if (l > i) cas(v[i], v[l]); }
}
__device__ __forceinline__ void sort16(float (&v)[16]) {
#pragma unroll
    for (int k = 2; k <= 16; k <<= 1)
#pragma unroll
        for (int j = k >> 1; j >= 1; j >>= 1)
#pragma unroll
            for (int i = 0; i < 16; ++i) { const int l = i ^ j; if (l > i) { if ((i & k) == 0) cas(v[i], v[l]); else cas(v[l], v[i]); } }
}
__device__ __forceinline__ void top16_merge(float (&x)[16], const float (&y)[16]) {
#pragma unroll
    for (int i = 0; i < 16; ++i) x[i] = vmaxf(x[i], y[15 - i]);
    bitonic_merge16(x);
}
template <bool XLANE = true>
__device__ __forceinline__ void top16_of_acc(const f32x16 (&acc)[4], int hi, float (&out)[16]) {
    float l0[16], l1[16];
#pragma unroll
    for (int rt = 0; rt < 4; ++rt) { float v[16];
#pragma unroll
        for (int e = 0; e < 16; ++e) { const unsigned n = 32 * rt + (e & 3) + 8 * (e >> 2) + 4 * hi; const float sv = acc[rt][e];
            v[e] = __builtin_bit_cast(float, (__builtin_bit_cast(unsigned, sv) & ~0x7Fu) | n); }
        __builtin_amdgcn_sched_barrier(0); sort16(v); __builtin_amdgcn_sched_barrier(0);
        if (rt == 0) {
#pragma unroll
            for (int e = 0; e < 16; ++e) l0[e] = v[e];
        } else if (rt == 1) top16_merge(l0, v);
        else if (rt == 2) {
#pragma unroll
            for (int e = 0; e < 16; ++e) l1[e] = v[e];
        } else top16_merge(l1, v); }
    top16_merge(l0, l1);
    if (XLANE) {
#pragma unroll
        for (int e = 0; e < 16; ++e) l1[e] = __shfl_xor(l0[e], 32);
        top16_merge(l0, l1);
    }
#pragma unroll
    for (int e = 0; e < 16; ++e) out[e] = l0[e];
}
__device__ __forceinline__ void emit_topk(const float (&ab)[2][16], int hi, int* IDX, float* GATE, size_t tok, int hh) {
    float pcs[50]; int nc = 0;
#pragma unroll
    for (int i = 0; i < 16; ++i)
#pragma unroll
        for (int j = 0; j < 16; ++j) if ((i + 1) * (j + 1) <= 16) {
            const float c = __builtin_bit_cast(float, __builtin_bit_cast(unsigned, ab[0][i]) & ~0x7Fu) + __builtin_bit_cast(float, __builtin_bit_cast(unsigned, ab[1][j]) & ~0x7Fu);
            pcs[nc] = __builtin_bit_cast(float, (__builtin_bit_cast(unsigned, c) & ~0x3Fu) | (unsigned)nc); ++nc; }
    float thr, mx;
    {   float c0[16], c1[16];
#pragma unroll
        for (int e = 0; e < 16; ++e) { c0[e] = pcs[e]; c1[e] = pcs[16 + e]; }
        sort16(c0); __builtin_amdgcn_sched_barrier(0); sort16(c1); __builtin_amdgcn_sched_barrier(0); top16_merge(c0, c1); __builtin_amdgcn_sched_barrier(0);
#pragma unroll
        for (int e = 0; e < 16; ++e) c1[e] = pcs[32 + e];
        sort16(c1); __builtin_amdgcn_sched_barrier(0); top16_merge(c0, c1); __builtin_amdgcn_sched_barrier(0);
#pragma unroll
        for (int x = 48; x < 50; ++x) { float v = pcs[x];
#pragma unroll
            for (int e = 0; e < 16; ++e) cas(c0[e], v); }
        thr = c0[15]; mx = __builtin_bit_cast(float, __builtin_bit_cast(unsigned, c0[0]) & ~0x3Fu); }
    asm volatile("" : "+v"(thr), "+v"(mx));
    float den = 0.f;
#pragma unroll
    for (int q = 0; q < 50; ++q) { const float c = __builtin_bit_cast(float, __builtin_bit_cast(unsigned, pcs[q]) & ~0x3Fu); if (pcs[q] >= thr) den += __expf(c - mx); }
    const float rden = 1.f / den; int cnt = 0; nc = 0;
#pragma unroll
    for (int i = 0; i < 16; ++i)
#pragma unroll
        for (int j = 0; j < 16; ++j) if ((i + 1) * (j + 1) <= 16) {
            const float pc = pcs[nc]; ++nc; const float c = __builtin_bit_cast(float, __builtin_bit_cast(unsigned, pc) & ~0x3Fu);
            if (pc >= thr && hi == 0 && cnt < 16) {
                const int ex = (int)(((__builtin_bit_cast(unsigned, ab[0][i]) & 0x7Fu) << 7) | (__builtin_bit_cast(unsigned, ab[1][j]) & 0x7Fu));
                IDX[(size_t)tok * 128 + hh * 16 + cnt] = ex; GATE[(size_t)tok * 128 + hh * 16 + cnt] = __expf(c - mx) * rden; ++cnt; } }
}
__device__ __forceinline__ void peer_topk(Frame& F) {
    const bf16* Q = (const bf16*)F.out; const bf16* KEYS = (const bf16*)(F.ws + WS_KEYS); int* IDX = (int*)(F.ws + WS_IDX); float* GATE = (float*)(F.ws + WS_GATE);
    const int gw = F.vcu * NWAVES + F.wave, NGW = F.G * NWAVES;
    for (int it = gw; it < (T / 32) * 8; it += NGW) {
        const int hh = it & 7, t0 = (it >> 3) * 32, tok = t0 + (F.lane & 31), hi = F.lane >> 5;
        float ab[2][16];
#pragma unroll
        for (int p = 0; p < 2; ++p) {
            f32x16 acc[4];
#pragma unroll
            for (int rt = 0; rt < 4; ++rt)
#pragma unroll
                for (int e = 0; e < 16; ++e) acc[rt][e] = 0.f;
#pragma unroll 1
            for (int ks = 0; ks < 8; ++ks) { const bf16x8 bq = *(const GAS bf16x8*)(Q + (size_t)tok * 2048 + hh * 256 + p * 128 + 16 * ks + 8 * hi);
#pragma unroll
                for (int rt = 0; rt < 4; ++rt) { const bf16x8 ak = *(const GAS bf16x8*)(KEYS + ((size_t)(hh * 2 + p) * 128 + 32 * rt + (F.lane & 31)) * 128 + 16 * ks + 8 * hi);
                    acc[rt] = __builtin_amdgcn_mfma_f32_32x32x16_bf16(ak, bq, acc[rt], 0, 0, 0); } }
            top16_of_acc(acc, hi, ab[p]);
        }
        emit_topk(ab, hi, IDX, GATE, (size_t)tok, hh);
    }
}
__device__ __forceinline__ void peer_e1(Frame& F) {
    const bf16* XN = (const bf16*)(F.ws + WS_HN); const bf16* U = (const bf16*)(F.ws + WS_U); const int* IDX = (const int*)(F.ws + WS_IDX);
    const float* GATE = (const float*)(F.ws + WS_GATE); float* HID = (float*)(F.ws + WS_HID);
    LAS int* LST = (LAS int*)(F.lds + F.wave * 1024);
    for (int item = blockIdx.x; item < 8 * (T / 32); item += F.G) {
        const int slice = item & 7, tile = item >> 3;
        for (int tt = 0; tt < 4; ++tt) {
            const int tok = tile * 32 + F.wave * 4 + tt;
            const int e0 = IDX[(size_t)tok * 128 + F.lane], e1 = IDX[(size_t)tok * 128 + 64 + F.lane];
            const bool m0 = (e0 >> 11) == slice, m1 = (e1 >> 11) == slice;
            const unsigned long long b0 = __ballot(m0), b1 = __ballot(m1);
            const int n0 = __popcll(b0), n = n0 + __popcll(b1);
            const unsigned long long below = (1ull << F.lane) - 1ull;
            if (m0) { const int p = __popcll(b0 & below); LST[2 * p] = e0; LST[2 * p + 1] = F.lane; }
            if (m1) { const int p = n0 + __popcll(b1 & below); LST[2 * p] = e1; LST[2 * p + 1] = 64 + F.lane; }
            const v4u xa = *(const GAS v4u*)(XN + (size_t)tok * D + 8 * F.lane), xb = *(const GAS v4u*)(XN + (size_t)tok * D + 512 + 8 * F.lane);
            float xf[16];
#pragma unroll
            for (int e = 0; e < 4; ++e) { xf[2 * e] = bflo(xa[e]); xf[2 * e + 1] = bfhi(xa[e]); xf[8 + 2 * e] = bflo(xb[e]); xf[9 + 2 * e] = bfhi(xb[e]); }
            LDS_WAIT(); asm volatile("" ::: "memory");
            for (int base = 0; base < n; base += 64) {
                float res = 0.f; const int lim = (n - base) < 64 ? (n - base) : 64;
                for (int q = 0; q < lim; q += 4) {
                    v4u ra[4], rb[4];
#pragma unroll
                    for (int u = 0; u < 4; ++u) { const int qq = (q + u) < lim ? (q + u) : (lim - 1); const int ex = __builtin_amdgcn_readfirstlane(LST[2 * (base + qq)]);
                        const bf16* row = U + (size_t)ex * D; ra[u] = *(const GAS v4u*)(row + 8 * F.lane); rb[u] = *(const GAS v4u*)(row + 512 + 8 * F.lane); }
#pragma unroll
                    for (int u = 0; u < 4; ++u) { float a = 0.f;
#pragma unroll
                        for (int e = 0; e < 4; ++e) { a += xf[2 * e] * bflo(ra[u][e]) + xf[2 * e + 1] * bfhi(ra[u][e]); a += xf[8 + 2 * e] * bflo(rb[u][e]) + xf[9 + 2 * e] * bfhi(rb[u][e]); }
                        a = wave_sum(a); if (F.lane == q + u) res = a; }
                }
                if (F.lane < lim) { const int pi = LST[2 * (base + F.lane) + 1]; const float g = GATE[(size_t)tok * 128 + pi];
                    HID[(size_t)tok * 128 + pi] = 0.5f * res * (1.f + erff(res * 0.70710678118654752f)) * g; }
            }
            LDS_WAIT(); asm volatile("" ::: "memory");
        }
    }
}
__device__ __forceinline__ void peer_e2(Frame& F) {
    const bf16* VS = (const bf16*)(F.ws + WS_VS); const int* IDX = (const int*)(F.ws + WS_IDX); const float* HID = (const float*)(F.ws + WS_HID);
    const float* H = (const float*)(F.ws + WS_H); float* SS2 = (float*)(F.ctl + CW_SS2);
    const int gq = F.lane >> 4, c = F.lane & 15;
    for (int item = blockIdx.x; item < 8 * (T / 32); item += F.G) {
        const int slice = item & 7, tile = item >> 3;
        const bf16* vs = VS + (size_t)slice * 16384 * 128 + 8 * c;
        for (int tt = 0; tt < 4; ++tt) {
            const int tok = tile * 32 + F.wave * 4 + tt;
            const int idA = IDX[(size_t)tok * 128 + F.lane], idB = IDX[(size_t)tok * 128 + 64 + F.lane];
            const float hA = HID[(size_t)tok * 128 + F.lane], hB = HID[(size_t)tok * 128 + 64 + F.lane];
            float acc[8];
#pragma unroll
            for (int e = 0; e < 8; ++e) acc[e] = 0.f;
#pragma unroll
            for (int s8 = 0; s8 < 32; s8 += 8) {
                v4u rv[8]; float hd[8];
#pragma unroll
                for (int u = 0; u < 8; ++u) { const int s = s8 + u; const int src = (4 * s + gq) & 63; const int ex = __shfl(s < 16 ? idA : idB, src); hd[u] = __shfl(s < 16 ? hA : hB, src);
                    rv[u] = *(const GAS v4u*)(vs + (size_t)ex * 128); }
#pragma unroll
                for (int u = 0; u < 8; ++u)
#pragma unroll
                    for (int e = 0; e < 4; ++e) { acc[2 * e] += hd[u] * bflo(rv[u][e]); acc[2 * e + 1] += hd[u] * bfhi(rv[u][e]); }
            }
#pragma unroll
            for (int e = 0; e < 8; ++e) { acc[e] += __shfl_xor(acc[e], 16); acc[e] += __shfl_xor(acc[e], 32); }
            float ss = 0.f;
            if (gq == 0) { const size_t o = (size_t)tok * D + slice * 128 + 8 * c; const f32x4 h0 = *(const GAS f32x4*)(H + o), h1 = *(const GAS f32x4*)(H + o + 4);
#if DBG == 1
#pragma unroll
                for (int e = 0; e < 8; ++e) acc[e] = 0.f;
#endif
#if DBG == 5
#pragma unroll
                for (int e = 0; e < 8; ++e) acc[e] = -acc[e];
#endif
                f32x4 o0 = h0 + (f32x4){acc[0], acc[1], acc[2], acc[3]}, o1 = h1 + (f32x4){acc[4], acc[5], acc[6], acc[7]};
                *(GAS f32x4*)(F.out + o) = o0; *(GAS f32x4*)(F.out + o + 4) = o1;
                ss = (o0.x * o0.x + o0.y * o0.y) + (o0.z * o0.z + o0.w * o0.w) + (o1.x * o1.x + o1.y * o1.y) + (o1.z * o1.z + o1.w * o1.w); }
#pragma unroll
            for (int o2 = 1; o2 < 16; o2 <<= 1) ss += __shfl_xor(ss, o2);
            if (F.lane == 0) atomicAdd(SS2 + tok, ss);
        }
    }
}
__device__ __forceinline__ void final_norm(Frame& F) {
    const int gw = F.vcu * NWAVES + F.wave, NGW = F.G * NWAVES; const float* SS2 = (const float*)(F.ctl + CW_SS2);
    const float dg = 1.f + fminf(__hip_atomic_load((const float*)(F.ctl + 2048), RLX_AGENT), 10.f);
    for (int m = gw; m < T; m += NGW) { const float rstd = dg / sqrtf(__hip_atomic_load(SS2 + m, RLX_AGENT) * (1.f / D) + EPS);
        GAS f32x4* p = (GAS f32x4*)(F.out + (size_t)m * D) + F.lane;
#pragma unroll
        for (int j = 0; j < 4; ++j) { const f32x4 w = *((const GAS f32x4*)F.A->in[17] + F.lane + 64 * j); p[64 * j] = p[64 * j] * rstd * w; } }
}

#if DBG == 6
__device__ __forceinline__ void peer_check(Frame& F) {
    if (blockIdx.x != 0 || F.wave >= 4) return;
    const int toks[4] = {5, 4101, 9000, 16000}; const int tok = toks[F.wave];
    const bf16* XN = (const bf16*)(F.ws + WS_HN); const int* IDX = (const int*)(F.ws + WS_IDX); const float* GATE = (const float*)(F.ws + WS_GATE); const float* H = (const float*)(F.ws + WS_H);
    float xf[16], o[16];
#pragma unroll
    for (int e = 0; e < 16; ++e) { xf[e] = bf1(XN[(size_t)tok * D + 64 * e + F.lane]); o[e] = 0.f; }
    for (int i = 0; i < 128; ++i) { const int ex = IDX[(size_t)tok * 128 + i]; float a = 0.f;
#pragma unroll
        for (int e = 0; e < 16; ++e) a += xf[e] * F.A->in[15][(size_t)ex * D + 64 * e + F.lane];
        a = wave_sum(a); const float hd = 0.5f * a * (1.f + erff(a * 0.70710678118654752f)) * GATE[(size_t)tok * 128 + i];
#pragma unroll
        for (int e = 0; e < 16; ++e) o[e] += hd * F.A->in[16][(size_t)ex * D + 64 * e + F.lane]; }
    float num = 0.f, den = 0.f;
#pragma unroll
    for (int e = 0; e < 16; ++e) { const float mine = F.out[(size_t)tok * D + 64 * e + F.lane] - H[(size_t)tok * D + 64 * e + F.lane]; num += (mine - o[e]) * (mine - o[e]); den += o[e] * o[e]; }
    num = wave_sum(num); den = wave_sum(den);
    if (F.lane == 0) atomicAdd((float*)(F.ctl + 2048) , sqrtf(num / den) * 0.25f);
}
#endif

#if DBG == 7
__device__ __forceinline__ void topk_check(Frame& F) {
    if (blockIdx.x != 0 || F.wave >= 4) return;
    const int toks[4] = {5, 4101, 9000, 16000}; const int hs[4] = {0, 3, 5, 7}; const int tok = toks[F.wave], hh = hs[F.wave];
    const bf16* Q = (const bf16*)F.out; const bf16* KEYS = (const bf16*)(F.ws + WS_KEYS); const int* IDX = (const int*)(F.ws + WS_IDX); const float* GATE = (const float*)(F.ws + WS_GATE);
    LAS float* S = (LAS float*)(F.lds + 4096 * F.wave);
    for (int p = 0; p < 2; ++p) for (int r = 0; r < 2; ++r) { const int n = F.lane + 64 * r; float a = 0.f;
        for (int d = 0; d < 128; ++d) a += bf1(Q[(size_t)tok * 2048 + hh * 256 + p * 128 + d]) * bf1(KEYS[((size_t)(hh * 2 + p) * 128 + n) * 128 + d]);
        S[p * 128 + n] = a; }
    LDS_WAIT(); asm volatile("" ::: "memory");
    float cmin = 1e30f, cmax = -1e30f; float cs[16];
    for (int i = 0; i < 16; ++i) { const int ex = IDX[(size_t)tok * 128 + hh * 16 + i]; cs[i] = S[ex >> 7] + S[128 + (ex & 127)]; cmin = fminf(cmin, cs[i]); cmax = fmaxf(cmax, cs[i]); }
    float den = 0.f; for (int i = 0; i < 16; ++i) den += __expf(cs[i] - cmax);
    float gerr = 0.f; for (int i = 0; i < 16; ++i) gerr = fmaxf(gerr, fabsf(__expf(cs[i] - cmax) / den - GATE[(size_t)tok * 128 + hh * 16 + i]));
    int cnt = 0;
    for (int i = 0; i < 128; ++i) for (int r = 0; r < 2; ++r) cnt += (S[i] + S[128 + F.lane + 64 * r] > cmin + 1e-4f) ? 1 : 0;
    const float tot = wave_sum((float)cnt);
    if (F.lane == 0) atomicAdd((float*)(F.ctl + 2048), 0.25f * (fminf(fabsf(tot - 15.f), 16.f) / 16.f + 10.f * gerr));
}
#endif

#if DBG == 10
__device__ __forceinline__ void topk_check(Frame& F) {
    if (blockIdx.x != 0 || F.wave >= 1) return;
    const bf16* Q = (const bf16*)F.out; const bf16* KEYS = (const bf16*)(F.ws + WS_KEYS); LAS float* SCR = (LAS float*)F.lds;
    const int hi = F.lane >> 5, tok = F.lane & 31;
    f32x16 acc[4];
#pragma unroll
    for (int rt = 0; rt < 4; ++rt)
#pragma unroll
        for (int e = 0; e < 16; ++e) acc[rt][e] = 0.f;
#pragma unroll 1
    for (int ks = 0; ks < 8; ++ks) { const bf16x8 bq = *(const GAS bf16x8*)(Q + (size_t)tok * 2048 + 16 * ks + 8 * hi);
#pragma unroll
        for (int rt = 0; rt < 4; ++rt) { const bf16x8 ak = *(const GAS bf16x8*)(KEYS + ((size_t)(32 * rt + (F.lane & 31))) * 128 + 16 * ks + 8 * hi);
            acc[rt] = __builtin_amdgcn_mfma_f32_32x32x16_bf16(ak, bq, acc[rt], 0, 0, 0); } }
#pragma unroll
    for (int rt = 0; rt < 4; ++rt)
#pragma unroll
        for (int e = 0; e < 16; ++e) SCR[(F.lane & 31) * 128 + 32 * rt + (e & 3) + 8 * (e >> 2) + 4 * hi] = acc[rt][e];
    LDS_WAIT(); asm volatile("" ::: "memory");
    float num = 0.f, den = 0.f;
    for (int tk = 0; tk < 32; tk += 5) for (int r = 0; r < 2; ++r) { const int n = F.lane + 64 * r; float a = 0.f;
        for (int d = 0; d < 128; ++d) a += bf1(Q[(size_t)tk * 2048 + d]) * bf1(KEYS[(size_t)n * 128 + d]);
        const float m = SCR[tk * 128 + n]; num += (m - a) * (m - a); den += a * a; }
    num = wave_sum(num); den = wave_sum(den);
    if (F.lane == 0) atomicAdd((float*)(F.ctl + 2048), sqrtf(num / den));
}
#endif

#if DBG == 11
__device__ __forceinline__ void topk_check(Frame& F) {
    if (blockIdx.x != 0 || F.wave >= 1) return;
    const bf16* Q = (const bf16*)F.out; const bf16* KEYS = (const bf16*)(F.ws + WS_KEYS); const int* IDX = (const int*)(F.ws + WS_IDX);
    int* IDX2 = (int*)(F.ws + WS_HID); float* GATE2 = (float*)(F.ws + WS_HID + 4 * MiB);
    LAS float* S = (LAS float*)F.lds;
    const int hi = F.lane >> 5, tok = F.lane & 31;
    for (int p = 0; p < 2; ++p) for (int j = 0; j < 64; ++j) { const int n = 64 * hi + j; float a = 0.f;
        for (int d = 0; d < 128; ++d) a += bf1(Q[(size_t)tok * 2048 + p * 128 + d]) * bf1(KEYS[((size_t)p * 128 + n) * 128 + d]);
        S[(tok * 2 + p) * 128 + n] = a + (DBGV == 3 ? 8.0f : 0.f); }
    LDS_WAIT(); asm volatile("" ::: "memory");
    float ab[2][16];
#pragma unroll
    for (int p = 0; p < 2; ++p) { f32x16 acc[4];
#pragma unroll
        for (int rt = 0; rt < 4; ++rt)
#pragma unroll
            for (int e = 0; e < 16; ++e) acc[rt][e] = S[(tok * 2 + p) * 128 + 32 * rt + (e & 3) + 8 * (e >> 2) + 4 * hi];
#if DBGV == 1
        {
            float prev = 3.0e38f;
#pragma unroll
            for (int r = 0; r < 16; ++r) { float best = -3.0e38f;
#pragma unroll 1
                for (int n = 0; n < 128; ++n) { const float v = __builtin_bit_cast(float, (__builtin_bit_cast(unsigned, S[(tok * 2 + p) * 128 + n]) & ~0x7Fu) | (unsigned)n); if (v < prev && v > best) best = v; }
                ab[p][r] = best; prev = best; }
        }
#elif DBGV == 2 || DBGV == 3
        {   float la[16], lb[16];
            top16_of_acc<false>(acc, hi, la);
#pragma unroll
            for (int rt = 0; rt < 4; ++rt)
#pragma unroll
                for (int e = 0; e < 16; ++e) acc[rt][e] = S[(tok * 2 + p) * 128 + 32 * rt + (e & 3) + 8 * (e >> 2) + 4 * (1 - hi)];
            top16_of_acc<false>(acc, 1 - hi, lb);
            top16_merge(la, lb);
#pragma unroll
            for (int e = 0; e < 16; ++e) ab[p][e] = la[e]; }
#else
        top16_of_acc(acc, hi, ab[p]);
#endif
    }
    emit_topk(ab, hi, IDX2, GATE2, (size_t)tok, 0);
    asm volatile("s_waitcnt vmcnt(0)" ::: "memory"); __builtin_amdgcn_fence(__ATOMIC_ACQ_REL, "agent");
    float d1 = 0.f, d2 = 0.f;
    if (hi == 0) {
#pragma unroll 1
        for (int i = 0; i < 16; ++i) { const int ex = __hip_atomic_load(IDX2 + (size_t)tok * 128 + i, RLX_AGENT); bool f = false;
#pragma unroll 1
            for (int j = 0; j < 16; ++j) f |= (IDX[(size_t)tok * 128 + j] == ex); d1 += f ? 0.f : 1.f; }
        float cmin = 1e30f;
#pragma unroll 1
        for (int i = 0; i < 16; ++i) { const int ex = __hip_atomic_load(IDX2 + (size_t)tok * 128 + i, RLX_AGENT); cmin = fminf(cmin, S[(tok * 2) * 128 + (ex >> 7)] + S[(tok * 2 + 1) * 128 + (ex & 127)]); }
        int cnt = 0;
#pragma unroll 1
        for (int i = 0; i < 128; ++i)
#pragma unroll 4
            for (int j = 0; j < 128; ++j) cnt += (S[(tok * 2) * 128 + i] + S[(tok * 2 + 1) * 128 + j] > cmin + 1e-4f) ? 1 : 0;
        d2 = fminf(fabsf((float)cnt - 15.f), 16.f);
    }
    d1 = wave_sum(d1) / 512.f; d2 = wave_sum(d2) / 512.f;
    if (F.lane == 0) atomicAdd((float*)(F.ctl + 2048), d1 + 4.f * d2);
}
#endif

__global__ void __launch_bounds__(NTHR, 2) mk_fwd(Args args) {
    extern __shared__ __attribute__((aligned(16))) unsigned char lds[];
    Frame F;
    F.lds = (LAS unsigned char*)lds;
    F.MISC = (volatile LAS unsigned*)(F.lds + MISC_OFF);
    F.tid = threadIdx.x; F.lane = F.tid & 63; F.wave = __builtin_amdgcn_readfirstlane(F.tid >> 6);
    F.G = gridDim.x; { const int bx = blockIdx.x; F.vcu = (F.G % 8 == 0) ? (bx % 8) * (F.G / 8) + bx / 8 : bx; }
    F.ws = args.ws; F.ctl = (gu32*)(args.ws + WS_CTL); F.out = args.out;
    F.A = &args;
    for (int u = F.tid; u < (LDS_BYTES - RING_BYTES) / 4; u += NTHR) ((LAS unsigned*)(F.lds + RING_BYTES))[u] = 0u;
    __syncthreads();
    XcdBarrier bar; bar.bar = (unsigned*)(F.ctl + CW_BAR); bar.x = 0; bar.st = nullptr;
    if (!MK_PER_PHASE) bar = xcd_barrier_post((unsigned*)(F.ctl + CW_BAR), F.MISC + 8);
    const int lo = args.ph_lo, hi = args.ph_hi;
#ifndef PH_MASK
#define PH_MASK 0xFFFF
#endif
#define IN(k) (((PH_MASK >> (k)) & 1) && lo <= (k) && (k) < hi)
#define SEAM(k) do { if (IN(k) && IN((k) + 1)) xcd_barrier(bar); } while (0)
    bf16* HN = (bf16*)(F.ws + WS_HN); bf16* PROJ = (bf16*)(F.ws + WS_PROJ); bf16* WIN = (bf16*)(F.ws + WS_WIN);

    if (IN(0)) { p0_prologue(F); } SEAM(0);
    if (IN(1)) {
        pg8::Gemm g{HN, WIN, T, NA, D}; pg8::StaticOrder S; S.init(T, NA, F.G, (int)blockIdx.x);
        pg8::EpiBf16<0> E{PROJ, NA, nullptr, 0, 0, 1.f};
        pg8::gemm_phase<pg8::EpiBf16<0>, pg8::StaticOrder, true, true>(F.lds, g, S, E);
    } SEAM(1);
    if (IN(2)) { ssd_pass_a(F); } SEAM(2);
    if (IN(3)) { ssd_scan(F); } SEAM(3);
    if (IN(4)) { ssd_pass_b(F); } SEAM(4);
    if (IN(5)) {
        ssd_norm(F);
        pg8::Gemm g{HN, WIN + (size_t)NA * D, T, NB_, D}; pg8::StaticOrder S; S.init(T, NB_, F.G, (int)blockIdx.x);
        EpiG1b E{PROJ, F.A->in[9]};
        pg8::gemm_phase<EpiG1b, pg8::StaticOrder, true, true>(F.lds, g, S, E);
    } SEAM(5);
    if (IN(6)) { hg_pass<false>(F); } SEAM(6);
    if (IN(7)) { hg_scan(F); } SEAM(7);
    if (IN(8)) { hg_pass<true>(F); } SEAM(8);
    if (IN(9)) {
        pg8::Gemm g{(const bf16*)F.out, (const bf16*)(F.ws + WS_WOUT), T, D, 2048}; pg8::StaticOrder S; S.init(T, D, F.G, (int)blockIdx.x);
        EpiRes E{F.A->in[0], (float*)(F.ws + WS_H)};
        pg8::gemm_phase<EpiRes, pg8::StaticOrder, true, true>(F.lds, g, S, E);
    } SEAM(9);
    if (IN(10)) { peer_prep(F); } SEAM(10);
    if (IN(11)) {
        pg8::Gemm g{HN, (const bf16*)(F.ws + WS_WQ), T, 2048, D}; pg8::StaticOrder S; S.init(T, 2048, F.G, (int)blockIdx.x);
        pg8::EpiBf16<0> E{(bf16*)F.out, 2048, nullptr, 0, 0, 1.f};
        pg8::gemm_phase<pg8::EpiBf16<0>, pg8::StaticOrder, true, true>(F.lds, g, S, E);
    } SEAM(11);
    if (IN(12)) { peer_topk(F); } SEAM(12);
    if (IN(13)) { peer_e1(F); } SEAM(13);
    if (IN(14)) { peer_e2(F); } SEAM(14);
#if DBG == 7 || DBG == 10 || DBG == 11
    if (lo == 100) { topk_check(F); return; }
#endif
#if DBG == 6
    if (lo == 15) { peer_check(F); return; }
    if (lo == 16) { final_norm(F); return; }
#endif
    if (IN(15)) { final_norm(F); }
#undef IN
#undef SEAM
}

extern "C" void kernel_launch(void* const* d_in, const int* in_sizes, int n_in, void* d_out, int out_size, void* d_ws, size_t ws_size, hipStream_t stream) {
    static int grid = 0;
    if (grid == 0) {
        if (n_in != 18 || out_size != T * D || ws_size < WS_END) { fprintf(stderr, "kernel_launch: unexpected shapes (n_in %d, out %d, ws %zu)\n", n_in, out_size, ws_size); grid = -1; return; }
        int dev = 0, cus = 0, per_cu = 0;
        if (hipGetDevice(&dev) != hipSuccess || hipDeviceGetAttribute(&cus, hipDeviceAttributeMultiprocessorCount, dev) != hipSuccess) { grid = -1; return; }
        if (hipFuncSetAttribute((const void*)mk_fwd, hipFuncAttributeMaxDynamicSharedMemorySize, LDS_BYTES) != hipSuccess) { fprintf(stderr, "kernel_launch: hipFuncSetAttribute failed\n"); grid = -1; return; }
        if (hipOccupancyMaxActiveBlocksPerMultiprocessor(&per_cu, (const void*)mk_fwd, NTHR, LDS_BYTES) != hipSuccess || per_cu < 1) { fprintf(stderr, "kernel_launch: occupancy query says %d blocks per CU\n", per_cu); grid = -1; (void)hipGetLastError(); return; }
        (void)hipGetLastError();
        grid = cus;
    }
    if (grid < 0) return;
    (void)hipMemsetAsync((char*)d_ws + WS_CTL, 0, CTL_ZERO_BYTES, stream);
    Args a{};
    for (int i = 0; i < 18; ++i) a.in[i] = (const float*)d_in[i];
    a.out = (float*)d_out; a.ws = (unsigned char*)d_ws;
#if MK_PER_PHASE
    for (int p = 0; p < NPH + (DBG == 6); ++p) { a.ph_lo = p; a.ph_hi = p + 1; hipLaunchKernelGGL(mk_fwd, dim3(grid), dim3(NTHR), LDS_BYTES, stream, a);
        if ((DBG == 7 || DBG == 10 || DBG == 11) && p == 12) { a.ph_lo = 100; a.ph_hi = 101; hipLaunchKernelGGL(mk_fwd, dim3(grid), dim3(NTHR), LDS_BYTES, stream, a); } }
#else
    a.ph_lo = 0; a.ph_hi = NPH; hipLaunchKernelGGL(mk_fwd, dim3(grid), dim3(NTHR), LDS_BYTES, stream, a);
#endif
}
```
